# Optimizing an MI355X kernel written in HIP

```python
import jax, jax.numpy as jnp
from jax import lax
import numpy as np

D_MODEL = 1024
BATCH = 8
SEQ = 2048
DEPTH = 1

D_MIX = D_MODEL
N_DN_HEADS = 4
DN_HEAD_DIM = 128
D_DN = N_DN_HEADS * DN_HEAD_DIM
D_SC = D_MIX - D_DN
N_SC_GROUPS = 4
DN_CONV = 4
SC_CONV = 3
CHUNK = 64
D_FF = 4 * D_MODEL
EPS = 1e-6
D_IN = 4 * D_DN + 2 * N_DN_HEADS + 3 * D_SC
SPLIT_OFFSETS = (3 * D_DN, 4 * D_DN, 4 * D_DN + N_DN_HEADS, 4 * D_DN + 2 * N_DN_HEADS,
                 4 * D_DN + 2 * N_DN_HEADS + D_SC, 4 * D_DN + 2 * N_DN_HEADS + 2 * D_SC)

kernel_name = "hymba_deltanet_shortconv_adaln_sandwich"


def rmsnorm(x, w):
    xf = x.astype(jnp.float32)
    y = xf * lax.rsqrt(jnp.mean(xf * xf, axis=-1, keepdims=True) + EPS)
    return (y * w.astype(jnp.float32)).astype(x.dtype)


def l2norm(t):
    return t * lax.rsqrt(jnp.sum(t * t, axis=-1, keepdims=True) + EPS)


def causal_depthwise_conv(x, w):
    width = w.shape[0]
    return lax.conv_general_dilated(
        x, w[:, None, :].astype(x.dtype), window_strides=(1,), padding=[(width - 1, 0)],
        dimension_numbers=('NWC', 'WIO', 'NWC'), feature_group_count=x.shape[-1])


def gated_delta_rule_chunked(q, k, v, g, beta):
    bsz, seq, nh, dh = q.shape
    n = seq // CHUNK

    def chunks(t):
        t = t.reshape((bsz, n, CHUNK, nh) + t.shape[3:])
        return jnp.moveaxis(jnp.moveaxis(t, 1, 0), 3, 2)

    q = chunks(q * (dh ** -0.5))
    k = chunks(k)
    v = chunks(v)
    beta = chunks(beta)
    g_cum = jnp.cumsum(chunks(g), axis=-1)

    tri_incl = jnp.tril(jnp.ones((CHUNK, CHUNK), dtype=bool))
    tri_strict = jnp.tril(jnp.ones((CHUNK, CHUNK), dtype=bool), -1)
    diff = g_cum[..., :, None] - g_cum[..., None, :]
    decay = jnp.exp(jnp.where(tri_incl, diff, -jnp.inf))

    k_beta = k * beta[..., None]
    v_beta = v * beta[..., None]
    m = jnp.where(tri_strict, jnp.einsum('nbhid,nbhjd->nbhij', k_beta, k) * decay, 0.0)
    eye = jnp.eye(CHUNK, dtype=m.dtype)
    t_inv = lax.linalg.triangular_solve(m + eye, jnp.broadcast_to(eye, m.shape),
                                        left_side=True, lower=True, unit_diagonal=True)
    u = jnp.einsum('nbhij,nbhjd->nbhid', t_inv, v_beta)
    w = jnp.einsum('nbhij,nbhjd->nbhid', t_inv, k_beta * jnp.exp(g_cum)[..., None])
    attn = jnp.einsum('nbhid,nbhjd->nbhij', q, k) * decay

    def step(state, inp):
        q_c, k_c, u_c, w_c, a_c, g_c = inp
        v_new = u_c - jnp.einsum('bhcd,bhde->bhce', w_c, state)
        o_c = (jnp.einsum('bhcd,bhde->bhce', q_c * jnp.exp(g_c)[..., None], state)
               + jnp.einsum('bhij,bhje->bhie', a_c, v_new))
        g_last = g_c[..., -1]
        k_dec = k_c * jnp.exp(g_last[..., None] - g_c)[..., None]
        state = (state * jnp.exp(g_last)[..., None, None]
                 + jnp.einsum('bhcd,bhce->bhde', k_dec, v_new))
        return state, o_c

    s0 = jnp.zeros((bsz, nh, dh, dh), dtype=q.dtype)
    _, o = lax.scan(step, s0, (q, k, u, w, attn, g_cum))
    o = jnp.moveaxis(jnp.moveaxis(o, 2, 3), 0, 1)
    return o.reshape(bsz, seq, nh, dh)


def token_mixer(h, w_in, dn_conv_w, dn_a_log, dn_dt_bias, dn_norm_w, sc_conv_w, w_out):
    bsz, seq, _ = h.shape
    proj = h @ w_in
    qkv, z, a, b, s_b, s_c, s_h = jnp.split(proj, SPLIT_OFFSETS, axis=-1)

    qkv = jax.nn.silu(causal_depthwise_conv(qkv, dn_conv_w)).astype(jnp.float32)
    q, k, v = [t.reshape(bsz, seq, N_DN_HEADS, DN_HEAD_DIM) for t in jnp.split(qkv, 3, axis=-1)]
    q, k = l2norm(q), l2norm(k)
    g = -jnp.exp(dn_a_log.astype(jnp.float32)) * jax.nn.softplus(
        a.astype(jnp.float32) + dn_dt_bias.astype(jnp.float32))
    beta = jax.nn.sigmoid(b.astype(jnp.float32))
    o = gated_delta_rule_chunked(q, k, v, g, beta)
    zg = jax.nn.silu(z.astype(jnp.float32).reshape(bsz, seq, N_DN_HEADS, DN_HEAD_DIM))
    o_dn = (rmsnorm(o, dn_norm_w) * zg).astype(h.dtype).reshape(bsz, seq, D_DN)

    y_sc = s_b * causal_depthwise_conv(s_c * s_h, sc_conv_w)

    return jnp.concatenate([o_dn, y_sc], axis=-1) @ w_out


def setup_inputs(seed: int = 0) -> dict:
    key = jax.random.key(seed)
    ks = jax.random.split(key, 20)
    L, D = DEPTH, D_MODEL

    def nrm(k, shape, scale):
        return jax.random.normal(k, shape, jnp.float32) * scale

    def gain(k, shape):
        return 1.0 + 0.02 * jax.random.normal(k, shape, jnp.float32)

    dt = jnp.exp(jax.random.uniform(ks[9], (L, N_DN_HEADS), jnp.float32,
                                    float(np.log(1e-3)), float(np.log(1e-1))))
    return {
        "x": jax.random.normal(ks[0], (BATCH, SEQ, D), jnp.float32),
        "c": jax.random.normal(ks[1], (BATCH, D), jnp.float32),
        "w_ada": nrm(ks[2], (L, D, 6 * D), 0.5 * D ** -0.5),
        "b_ada": nrm(ks[3], (L, 6 * D), 0.01),
        "pre_mix_norm_w": gain(ks[4], (L, D)),
        "post_mix_norm_w": gain(ks[5], (L, D)),
        "w_in": nrm(ks[6], (L, D, D_IN), D ** -0.5),
        "dn_conv_w": nrm(ks[7], (L, DN_CONV, 3 * D_DN), DN_CONV ** -0.5),
        "dn_a_log": jnp.log(jax.random.uniform(ks[8], (L, N_DN_HEADS), jnp.float32, 1.0, 16.0)),
        "dn_dt_bias": dt + jnp.log(-jnp.expm1(-dt)),
        "dn_norm_w": gain(ks[10], (L, DN_HEAD_DIM)),
        "sc_conv_w": nrm(ks[11], (L, SC_CONV, D_SC), SC_CONV ** -0.5),
        "w_out": nrm(ks[12], (L, D_MIX, D), D_MIX ** -0.5),
        "pre_ffn_norm_w": gain(ks[13], (L, D)),
        "post_ffn_norm_w": gain(ks[14], (L, D)),
        "w_ff1": nrm(ks[15], (L, D, D_FF), D ** -0.5),
        "w_ff2": nrm(ks[16], (L, D_FF, D), D_FF ** -0.5),
    }


def reference(x, c, w_ada, b_ada, pre_mix_norm_w, post_mix_norm_w, w_in, dn_conv_w,
              dn_a_log, dn_dt_bias, dn_norm_w, sc_conv_w, w_out, pre_ffn_norm_w,
              post_ffn_norm_w, w_ff1, w_ff2):
    c_act = jax.nn.silu(c)
    for l in range(DEPTH):
        mod = (c_act @ w_ada[l] + b_ada[l])[:, None, :]
        sh_m, sc_m, g_m, sh_f, sc_f, g_f = jnp.split(mod, 6, axis=-1)

        h = rmsnorm(x, pre_mix_norm_w[l]) * (1.0 + sc_m) + sh_m
        y = token_mixer(h, w_in[l], dn_conv_w[l], dn_a_log[l], dn_dt_bias[l],
                        dn_norm_w[l], sc_conv_w[l], w_out[l])
        x = x + g_m * rmsnorm(y, post_mix_norm_w[l])

        h = rmsnorm(x, pre_ffn_norm_w[l]) * (1.0 + sc_f) + sh_f
        y = jnp.square(jax.nn.relu(h @ w_ff1[l])) @ w_ff2[l]
        x = x + g_f * rmsnorm(y, post_ffn_norm_w[l])
    return x
```

```cpp
#include <hip/hip_runtime.h>
#include <hip/hip_bf16.h>
#include <stdint.h>

typedef unsigned short bf16_t;
typedef float f32x4 __attribute__((ext_vector_type(4)));
typedef unsigned u32x2 __attribute__((ext_vector_type(2)));
typedef unsigned u32x4 __attribute__((ext_vector_type(4)));

constexpr int D = 1024, NB = 8, SEQ = 2048, M = NB * SEQ, DIN = 3592, DP = 3584, DFF = 4096;
constexpr int NH = 4, HD = 128;
constexpr float EPS = 1e-6f;
constexpr int OFF_Q = 0, OFF_K = 512, OFF_V = 1024, OFF_Z = 1536, OFF_SB = 2048, OFF_SC = 2560, OFF_SH = 3072;
constexpr int MOD_KS = 4;

constexpr size_t MiB = 1ull << 20;
constexpr size_t WS_WT_IN = 0, WS_WT_OUT = 7 * MiB, WS_WT_FF1 = 9 * MiB, WS_WT_FF2 = 17 * MiB;
constexpr size_t WS_MODP = 25 * MiB;
constexpr size_t WS_G = 25 * MiB + 768 * 1024;
constexpr size_t WS_BETA = 26 * MiB;
constexpr size_t WS_PROJ = 27 * MiB;
constexpr size_t WS_H = 139 * MiB;
constexpr size_t WS_O = 227 * MiB;
constexpr size_t WS_MIX = 139 * MiB;
constexpr size_t WS_Y = 27 * MiB;
constexpr size_t WS_HID = 27 * MiB;
constexpr size_t WS_H2 = 160 * MiB;
constexpr size_t WS_Y2 = 192 * MiB;

struct Params {
  const float *x, *c, *w_ada, *b_ada, *pre_mix_w, *post_mix_w, *w_in, *dn_conv_w, *dn_a_log, *dn_dt_bias,
      *dn_norm_w, *sc_conv_w, *w_out, *pre_ffn_w, *post_ffn_w, *w_ff1, *w_ff2;
  float* out;
  unsigned char* ws;
};

__device__ __forceinline__ bf16_t f2bf(float x) {
  unsigned u = __float_as_uint(x);
  u += 0x7fffu + ((u >> 16) & 1u);
  return (bf16_t)(u >> 16);
}
__device__ __forceinline__ float bf2f(bf16_t b) { return __uint_as_float(((unsigned)b) << 16); }
__device__ __forceinline__ unsigned pack2(float lo, float hi) { return (unsigned)f2bf(lo) | ((unsigned)f2bf(hi) << 16); }
__device__ __forceinline__ float bflo(unsigned u) { return __uint_as_float(u << 16); }
__device__ __forceinline__ float bfhi(unsigned u) { return __uint_as_float(u & 0xffff0000u); }
__device__ __forceinline__ float siluf(float x) { return x / (1.f + __expf(-x)); }
__device__ __forceinline__ float sigmoidf_(float x) { return 1.f / (1.f + __expf(-x)); }
__device__ __forceinline__ float softplusf_(float x) { return x > 20.f ? x : log1pf(expf(x)); }

__device__ __forceinline__ float wave_sum(float v) {
#pragma unroll
  for (int o = 32; o >= 1; o >>= 1) v += __shfl_xor(v, o);
  return v;
}

__device__ __forceinline__ f32x4 load_mod4(const Params& P, int b, int col) {
  const float* mp = (const float*)(P.ws + WS_MODP);
  f32x4 v = *(const f32x4*)(P.b_ada + col);
#pragma unroll
  for (int s = 0; s < MOD_KS; ++s) v += *(const f32x4*)(mp + ((size_t)s * NB + b) * 6144 + col);
  return v;
}

__device__ void phase_mod(const Params& P, int item, float* lds) {
  const int ks = item / 48, cg = item % 48, t = threadIdx.x, kq = t >> 7, cl = t & 127;
  float* sc = lds;
  float* red = lds + 2048;
  __syncthreads();
  for (int i = t; i < 8 * 256; i += 512) { int b = i >> 8, k = i & 255; sc[i] = siluf(P.c[b * D + ks * 256 + k]); }
  __syncthreads();
  float acc[8];
#pragma unroll
  for (int b = 0; b < 8; ++b) acc[b] = 0.f;
  const float* wp = P.w_ada + (size_t)(ks * 256 + kq * 64) * 6144 + cg * 128 + cl;
  for (int k = 0; k < 64; ++k) {
    float w = wp[(size_t)k * 6144];
#pragma unroll
    for (int b = 0; b < 8; ++b) acc[b] += sc[b * 256 + kq * 64 + k] * w;
  }
#pragma unroll
  for (int b = 0; b < 8; ++b) red[(kq * 8 + b) * 128 + cl] = acc[b];
  __syncthreads();
  float* mp = (float*)(P.ws + WS_MODP);
  for (int i = t; i < 8 * 128; i += 512) {
    int b = i >> 7, c2 = i & 127;
    float s = red[(0 * 8 + b) * 128 + c2] + red[(1 * 8 + b) * 128 + c2] + red[(2 * 8 + b) * 128 + c2] + red[(3 * 8 + b) * 128 + c2];
    mp[((size_t)ks * NB + b) * 6144 + cg * 128 + c2] = s;
  }
}

__device__ void phase_prenorm(const Params& P, int bid, int nb, float* lds) {
  const int t = threadIdx.x, hf = t >> 8, u = t & 255, wv = t >> 6, lane = t & 63;
  const int rpb = M / nb, r0 = bid * rpb, b = r0 / SEQ;
  bf16_t* H = (bf16_t*)(P.ws + WS_H);
  float* G = (float*)(P.ws + WS_G);
  float* BETA = (float*)(P.ws + WS_BETA);
  f32x4 sh = load_mod4(P, b, 0 * D + 4 * u), sc = load_mod4(P, b, 1 * D + 4 * u);
  f32x4 wn = *(const f32x4*)(P.pre_mix_w + 4 * u);
  f32x4 mulv = wn * (sc + 1.0f);
  float wab[4][8];
#pragma unroll
  for (int kk = 0; kk < 4; ++kk) {
    f32x4 a = *(const f32x4*)(P.w_in + (size_t)(4 * u + kk) * DIN + 2048);
    f32x4 c = *(const f32x4*)(P.w_in + (size_t)(4 * u + kk) * DIN + 2052);
#pragma unroll
    for (int j = 0; j < 4; ++j) { wab[kk][j] = a[j]; wab[kk][4 + j] = c[j]; }
  }
  float* red_ss = lds;
  float* red_ab = lds + 16;
  __syncthreads();
  for (int it = 0; it < rpb / 2; ++it) {
    const int row = r0 + 2 * it + hf, par = it & 1;
    f32x4 xv = *(const f32x4*)(P.x + (size_t)row * D + 4 * u);
    float ss = xv[0] * xv[0] + xv[1] * xv[1] + xv[2] * xv[2] + xv[3] * xv[3];
    ss = wave_sum(ss);
    if (lane == 0) red_ss[par * 8 + wv] = ss;
    __syncthreads();
    float tot = red_ss[par * 8 + hf * 4 + 0] + red_ss[par * 8 + hf * 4 + 1] + red_ss[par * 8 + hf * 4 + 2] + red_ss[par * 8 + hf * 4 + 3];
    float rstd = rsqrtf(tot * (1.0f / D) + EPS);
    f32x4 hv = xv * rstd * mulv + sh;
    u32x2 pk; pk[0] = pack2(hv[0], hv[1]); pk[1] = pack2(hv[2], hv[3]);
    *(u32x2*)(H + (size_t)row * D + 4 * u) = pk;
    float pa[8];
#pragma unroll
    for (int j = 0; j < 8; ++j) pa[j] = hv[0] * wab[0][j] + hv[1] * wab[1][j] + hv[2] * wab[2][j] + hv[3] * wab[3][j];
#pragma unroll
    for (int j = 0; j < 8; ++j) pa[j] = wave_sum(pa[j]);
    if (lane == 0) {
#pragma unroll
      for (int j = 0; j < 8; ++j) red_ab[(par * 8 + wv) * 8 + j] = pa[j];
    }
    __syncthreads();
    if (u < 8) {
      float v = red_ab[(par * 8 + hf * 4 + 0) * 8 + u] + red_ab[(par * 8 + hf * 4 + 1) * 8 + u] + red_ab[(par * 8 + hf * 4 + 2) * 8 + u] + red_ab[(par * 8 + hf * 4 + 3) * 8 + u];
      if (u < 4) {
        float g = -expf(P.dn_a_log[u]) * softplusf_(v + P.dn_dt_bias[u]);
        G[(size_t)row * 4 + u] = g;
      } else {
        BETA[(size_t)row * 4 + (u - 4)] = sigmoidf_(v);
      }
    }
  }
}

template <class Epi>
__global__ void __launch_bounds__(256) k_gemm_naive(const bf16_t* A, const float* W, int K, int ldw, int N, int cmap_thresh, int cmap_add, Epi epi) {
  __shared__ float sA[16][64 + 1];
  __shared__ float sB[16][64 + 1];
  const int tx = threadIdx.x & 15, ty = threadIdx.x >> 4;
  const int bn = blockIdx.x * 64, bm = blockIdx.y * 64;
  float acc[4][4] = {};
  for (int k0 = 0; k0 < K; k0 += 16) {
    for (int i = threadIdx.x; i < 64 * 16; i += 256) {
      int r = i >> 4, kk = i & 15;
      sA[kk][r] = bf2f(A[(size_t)(bm + r) * K + k0 + kk]);
    }
    for (int i = threadIdx.x; i < 16 * 64; i += 256) {
      int kk = i >> 6, n = i & 63;
      int col = bn + n; col = col >= cmap_thresh ? col + cmap_add : col;
      sB[kk][n] = W[(size_t)(k0 + kk) * ldw + col];
    }
    __syncthreads();
#pragma unroll
    for (int kk = 0; kk < 16; ++kk) {
      float a[4], b[4];
#pragma unroll
      for (int i = 0; i < 4; ++i) { a[i] = sA[kk][ty * 4 + i]; b[i] = sB[kk][tx * 4 + i]; }
#pragma unroll
      for (int i = 0; i < 4; ++i)
#pragma unroll
        for (int j = 0; j < 4; ++j) acc[i][j] += a[i] * b[j];
    }
    __syncthreads();
  }
#pragma unroll
  for (int i = 0; i < 4; ++i)
#pragma unroll
    for (int j = 0; j < 4; ++j) epi(bm + ty * 4 + i, bn + tx * 4 + j, acc[i][j]);
}
struct EpiStoreBf16 { bf16_t* O; int ldc; int pad; __device__ void operator()(int r, int c, float v) const { O[(size_t)r * ldc + c] = f2bf(v); } };
struct EpiStoreF32 { float* O; int ldc; int pad; __device__ void operator()(int r, int c, float v) const { O[(size_t)r * ldc + c] = v; } };
struct EpiRelu2Bf16 { bf16_t* O; int ldc; int pad; __device__ void operator()(int r, int c, float v) const { v = v > 0.f ? v : 0.f; O[(size_t)r * ldc + c] = f2bf(v * v); } };

__global__ void __launch_bounds__(256) k_dn_naive(Params P) {
  const int bh = blockIdx.x, b = bh >> 2, h = bh & 3, t = threadIdx.x, e = t & 127, hf = t >> 7, wv = t >> 6, lane = t & 63;
  const bf16_t* PROJ = (const bf16_t*)(P.ws + WS_PROJ);
  const float* G = (const float*)(P.ws + WS_G);
  const float* BETA = (const float*)(P.ws + WS_BETA);
  bf16_t* O = (bf16_t*)(P.ws + WS_O);
  __shared__ float sq[128], sk[128], sv[128], part[2][128], red[4];
  float s[64];
#pragma unroll
  for (int i = 0; i < 64; ++i) s[i] = 0.f;
  const int colA = (hf == 0 ? OFF_Q : OFF_K) + h * HD + e, colV = OFF_V + h * HD + e;
  float wa[4], wvv[4];
#pragma unroll
  for (int j = 0; j < 4; ++j) { wa[j] = P.dn_conv_w[j * 1536 + colA]; wvv[j] = P.dn_conv_w[j * 1536 + colV]; }
  float ra[3] = {0.f, 0.f, 0.f}, rv[3] = {0.f, 0.f, 0.f};
  for (int tk = 0; tk < SEQ; ++tk) {
    const size_t row = (size_t)b * SEQ + tk;
    float xa = bf2f(PROJ[row * DP + colA]);
    float ca = wa[0] * ra[0] + wa[1] * ra[1] + wa[2] * ra[2] + wa[3] * xa;
    ra[0] = ra[1]; ra[1] = ra[2]; ra[2] = xa;
    ca = siluf(ca);
    float ssq = wave_sum(ca * ca);
    if (lane == 0) red[wv] = ssq;
    float cv = 0.f;
    if (hf == 0) {
      float xv = bf2f(PROJ[row * DP + colV]);
      cv = wvv[0] * rv[0] + wvv[1] * rv[1] + wvv[2] * rv[2] + wvv[3] * xv;
      rv[0] = rv[1]; rv[1] = rv[2]; rv[2] = xv;
      cv = siluf(cv);
    }
    __syncthreads();
    float tot = red[hf * 2] + red[hf * 2 + 1];
    float nrm = ca * rsqrtf(tot + EPS);
    if (hf == 0) { sq[e] = nrm * 0.08838834764831845f; sv[e] = cv; } else { sk[e] = nrm; }
    __syncthreads();
    const float g = G[row * 4 + h], beta = BETA[row * 4 + h], eg = expf(g);
    float ks = 0.f;
#pragma unroll
    for (int i = 0; i < 64; ++i) { s[i] *= eg; ks += sk[hf * 64 + i] * s[i]; }
    part[hf][e] = ks;
    __syncthreads();
    const float delta = beta * (sv[e] - (part[0][e] + part[1][e]));
    float op = 0.f;
#pragma unroll
    for (int i = 0; i < 64; ++i) { s[i] += sk[hf * 64 + i] * delta; op += sq[hf * 64 + i] * s[i]; }
    __syncthreads();
    part[hf][e] = op;
    __syncthreads();
    if (hf == 0) O[row * 512 + h * HD + e] = f2bf(part[0][e] + part[1][e]);
  }
}

__device__ void phase_gate_mix(const Params& P, int bid, int nb) {
  const int t = threadIdx.x, hf = t >> 8, u = t & 255;
  const bf16_t* PROJ = (const bf16_t*)(P.ws + WS_PROJ);
  const bf16_t* O = (const bf16_t*)(P.ws + WS_O);
  bf16_t* MIX = (bf16_t*)(P.ws + WS_MIX);
  for (int rp = bid; rp < M / 2; rp += nb) {
    const int row = 2 * rp + hf, tk = row % SEQ;
    if (u < 128) {
      const int col = 4 * u;
      u32x2 ov = *(const u32x2*)(O + (size_t)row * 512 + col);
      float o0 = bflo(ov[0]), o1 = bfhi(ov[0]), o2 = bflo(ov[1]), o3 = bfhi(ov[1]);
      float ss = o0 * o0 + o1 * o1 + o2 * o2 + o3 * o3;
#pragma unroll
      for (int o = 16; o >= 1; o >>= 1) ss += __shfl_xor(ss, o);
      const float rstd = rsqrtf(ss * (1.0f / HD) + EPS);
      u32x2 zv = *(const u32x2*)(PROJ + (size_t)row * DP + OFF_Z + col);
      f32x4 nw = *(const f32x4*)(P.dn_norm_w + (col & 127));
      float r0 = o0 * rstd * nw[0] * siluf(bflo(zv[0])), r1 = o1 * rstd * nw[1] * siluf(bfhi(zv[0]));
      float r2 = o2 * rstd * nw[2] * siluf(bflo(zv[1])), r3 = o3 * rstd * nw[3] * siluf(bfhi(zv[1]));
      u32x2 pk; pk[0] = pack2(r0, r1); pk[1] = pack2(r2, r3);
      *(u32x2*)(MIX + (size_t)row * D + col) = pk;
    } else {
      const int col = 4 * (u - 128);
      float acc[4] = {0.f, 0.f, 0.f, 0.f};
#pragma unroll
      for (int j = 0; j < 3; ++j) {
        const int dt = 2 - j;
        if (tk - dt >= 0) {
          u32x2 cv = *(const u32x2*)(PROJ + (size_t)(row - dt) * DP + OFF_SC + col);
          u32x2 hv = *(const u32x2*)(PROJ + (size_t)(row - dt) * DP + OFF_SH + col);
          f32x4 w = *(const f32x4*)(P.sc_conv_w + j * 512 + col);
          acc[0] += w[0] * bflo(cv[0]) * bflo(hv[0]); acc[1] += w[1] * bfhi(cv[0]) * bfhi(hv[0]);
          acc[2] += w[2] * bflo(cv[1]) * bflo(hv[1]); acc[3] += w[3] * bfhi(cv[1]) * bfhi(hv[1]);
        }
      }
      u32x2 bv = *(const u32x2*)(PROJ + (size_t)row * DP + OFF_SB + col);
      u32x2 pk; pk[0] = pack2(acc[0] * bflo(bv[0]), acc[1] * bfhi(bv[0])); pk[1] = pack2(acc[2] * bflo(bv[1]), acc[3] * bfhi(bv[1]));
      *(u32x2*)(MIX + (size_t)row * D + 512 + col) = pk;
    }
  }
}

__device__ void phase_post1(const Params& P, int bid, int nb, float* lds) {
  const int t = threadIdx.x, hf = t >> 8, u = t & 255, wv = t >> 6, lane = t & 63;
  const int rpb = M / nb, r0 = bid * rpb, b = r0 / SEQ;
  const float* Y = (const float*)(P.ws + WS_Y);
  bf16_t* H2 = (bf16_t*)(P.ws + WS_H2);
  f32x4 gm = load_mod4(P, b, 2 * D + 4 * u), shf = load_mod4(P, b, 3 * D + 4 * u), scf = load_mod4(P, b, 4 * D + 4 * u);
  f32x4 wpost = *(const f32x4*)(P.post_mix_w + 4 * u), wpre = *(const f32x4*)(P.pre_ffn_w + 4 * u);
  f32x4 m1 = gm * wpost, m2 = wpre * (scf + 1.0f);
  float* red = lds;
  __syncthreads();
  for (int it = 0; it < rpb / 2; ++it) {
    const int row = r0 + 2 * it + hf, par = it & 1;
    f32x4 yv = *(const f32x4*)(Y + (size_t)row * D + 4 * u);
    f32x4 xv = *(const f32x4*)(P.x + (size_t)row * D + 4 * u);
    float ss = wave_sum(yv[0] * yv[0] + yv[1] * yv[1] + yv[2] * yv[2] + yv[3] * yv[3]);
    if (lane == 0) red[(par * 2 + 0) * 8 + wv] = ss;
    __syncthreads();
    const float* rr = red + (par * 2 + 0) * 8 + hf * 4;
    float rstd = rsqrtf((rr[0] + rr[1] + rr[2] + rr[3]) * (1.0f / D) + EPS);
    f32x4 x1 = xv + yv * rstd * m1;
    *(f32x4*)(P.out + (size_t)row * D + 4 * u) = x1;
    float ss2 = wave_sum(x1[0] * x1[0] + x1[1] * x1[1] + x1[2] * x1[2] + x1[3] * x1[3]);
    if (lane == 0) red[(par * 2 + 1) * 8 + wv] = ss2;
    __syncthreads();
    const float* rr2 = red + (par * 2 + 1) * 8 + hf * 4;
    float rstd2 = rsqrtf((rr2[0] + rr2[1] + rr2[2] + rr2[3]) * (1.0f / D) + EPS);
    f32x4 hv = x1 * rstd2 * m2 + shf;
    u32x2 pk; pk[0] = pack2(hv[0], hv[1]); pk[1] = pack2(hv[2], hv[3]);
    *(u32x2*)(H2 + (size_t)row * D + 4 * u) = pk;
  }
}

__device__ void phase_final(const Params& P, int bid, int nb, float* lds) {
  const int t = threadIdx.x, hf = t >> 8, u = t & 255, wv = t >> 6, lane = t & 63;
  const int rpb = M / nb, r0 = bid * rpb, b = r0 / SEQ;
  const float* Y2 = (const float*)(P.ws + WS_Y2);
  f32x4 gf = load_mod4(P, b, 5 * D + 4 * u);
  f32x4 wpost = *(const f32x4*)(P.post_ffn_w + 4 * u);
  f32x4 m1 = gf * wpost;
  float* red = lds;
  __syncthreads();
  for (int it = 0; it < rpb / 2; ++it) {
    const int row = r0 + 2 * it + hf, par = it & 1;
    f32x4 yv = *(const f32x4*)(Y2 + (size_t)row * D + 4 * u);
    f32x4 xv = *(const f32x4*)(P.out + (size_t)row * D + 4 * u);
    float ss = wave_sum(yv[0] * yv[0] + yv[1] * yv[1] + yv[2] * yv[2] + yv[3] * yv[3]);
    if (lane == 0) red[par * 8 + wv] = ss;
    __syncthreads();
    const float* rr = red + par * 8 + hf * 4;
    float rstd = rsqrtf((rr[0] + rr[1] + rr[2] + rr[3]) * (1.0f / D) + EPS);
    *(f32x4*)(P.out + (size_t)row * D + 4 * u) = xv + yv * rstd * m1;
  }
}

__global__ void __launch_bounds__(512) k_mod(Params P) {
  __shared__ float lds[2048 + 4096];
  for (int it = blockIdx.x; it < 192; it += gridDim.x) phase_mod(P, it, lds);
}
__global__ void __launch_bounds__(512) k_prenorm(Params P) { __shared__ float lds[256]; phase_prenorm(P, blockIdx.x, gridDim.x, lds); }
__global__ void __launch_bounds__(512) k_gate_mix(Params P) { phase_gate_mix(P, blockIdx.x, gridDim.x); }
__global__ void __launch_bounds__(512) k_post1(Params P) { __shared__ float lds[256]; phase_post1(P, blockIdx.x, gridDim.x, lds); }
__global__ void __launch_bounds__(512) k_final(Params P) { __shared__ float lds[256]; phase_final(P, blockIdx.x, gridDim.x, lds); }

extern "C" void kernel_launch(void* const* d_in, const int* in_sizes, int n_in, void* d_out, int out_size, void* d_ws, size_t ws_size,
                              hipStream_t stream) {
  Params P{};
  P.x = (const float*)d_in[0]; P.c = (const float*)d_in[1]; P.w_ada = (const float*)d_in[2]; P.b_ada = (const float*)d_in[3];
  P.pre_mix_w = (const float*)d_in[4]; P.post_mix_w = (const float*)d_in[5]; P.w_in = (const float*)d_in[6];
  P.dn_conv_w = (const float*)d_in[7]; P.dn_a_log = (const float*)d_in[8]; P.dn_dt_bias = (const float*)d_in[9];
  P.dn_norm_w = (const float*)d_in[10]; P.sc_conv_w = (const float*)d_in[11]; P.w_out = (const float*)d_in[12];
  P.pre_ffn_w = (const float*)d_in[13]; P.post_ffn_w = (const float*)d_in[14]; P.w_ff1 = (const float*)d_in[15];
  P.w_ff2 = (const float*)d_in[16];
  P.out = (float*)d_out; P.ws = (unsigned char*)d_ws;
  unsigned char* ws = P.ws;
  k_mod<<<192, 512, 0, stream>>>(P);
  k_prenorm<<<256, 512, 0, stream>>>(P);
  k_gemm_naive<<<dim3(DP / 64, M / 64), 256, 0, stream>>>((const bf16_t*)(ws + WS_H), P.w_in, D, DIN, DP, 2048, 8, EpiStoreBf16{(bf16_t*)(ws + WS_PROJ), DP, 0});
  k_dn_naive<<<32, 256, 0, stream>>>(P);
  k_gate_mix<<<256, 512, 0, stream>>>(P);
  k_gemm_naive<<<dim3(D / 64, M / 64), 256, 0, stream>>>((const bf16_t*)(ws + WS_MIX), P.w_out, D, D, D, 1 << 30, 0, EpiStoreF32{(float*)(ws + WS_Y), D, 0});
  k_post1<<<256, 512, 0, stream>>>(P);
  k_gemm_naive<<<dim3(DFF / 64, M / 64), 256, 0, stream>>>((const bf16_t*)(ws + WS_H2), P.w_ff1, D, DFF, DFF, 1 << 30, 0, EpiRelu2Bf16{(bf16_t*)(ws + WS_HID), DFF, 0});
  k_gemm_naive<<<dim3(D / 64, M / 64), 256, 0, stream>>>((const bf16_t*)(ws + WS_HID), P.w_ff2, DFF, D, D, 1 << 30, 0, EpiStoreF32{(float*)(ws + WS_Y2), D, 0});
  k_final<<<256, 512, 0, stream>>>(P);
}
```

```cpp
#include <hip/hip_runtime.h>
#include <hip/hip_bf16.h>
#include <hip/hip_cooperative_groups.h>
#include <stdint.h>
#include <cstdio>
namespace cg = cooperative_groups;

typedef unsigned short bf16_t;
typedef float f32x4 __attribute__((ext_vector_type(4)));
typedef unsigned u32x2 __attribute__((ext_vector_type(2)));
typedef unsigned u32x4 __attribute__((ext_vector_type(4)));

constexpr int D = 1024, NB = 8, SEQ = 2048, M = NB * SEQ, DIN = 3592, DP = 3584, DFF = 4096;
constexpr int NH = 4, HD = 128;
constexpr float EPS = 1e-6f;
constexpr int OFF_Q = 0, OFF_K = 512, OFF_V = 1024, OFF_Z = 1536, OFF_SB = 2048, OFF_SC = 2560, OFF_SH = 3072;
constexpr int MOD_KS = 4;

constexpr size_t MiB = 1ull << 20;
constexpr size_t WS_WT_IN = 0, WS_WT_OUT = 7 * MiB, WS_WT_FF1 = 9 * MiB, WS_WT_FF2 = 17 * MiB;
constexpr size_t WS_MODP = 25 * MiB;
constexpr size_t WS_G = 25 * MiB + 768 * 1024;
constexpr size_t WS_BETA = 26 * MiB;
constexpr size_t WS_PROJ = 27 * MiB;
constexpr size_t WS_H = 139 * MiB;
constexpr size_t WS_O = 227 * MiB;
constexpr size_t WS_MIX = 139 * MiB;
constexpr size_t WS_Y = 27 * MiB;
constexpr size_t WS_HID = 27 * MiB;
constexpr size_t WS_H2 = 160 * MiB;
constexpr size_t WS_Y2 = 192 * MiB;

namespace pg8 {
#define PG8_LAS __attribute__((address_space(3)))
typedef unsigned short bf16_t;
typedef short bf16x8 __attribute__((ext_vector_type(8)));
typedef float f32x4 __attribute__((ext_vector_type(4)));
typedef unsigned u32x4 __attribute__((ext_vector_type(4)));
constexpr int BM = 256, BK = 64, HALF = 128, HTB = HALF * BK * 2  , STAGE_BYTES = 8 * HTB, NXCD = 8, WGM = 8;

__host__ __device__ __forceinline__ int lds_byte(int r, int c) { const int st = (r >> 4) * 2 + (c >> 5), rr = r & 15, cc = c & 31, ob = rr * 64 + cc * 2; return st * 1024 + (ob ^ (((ob >> 9) & 1) << 5)); }
__host__ __device__ __forceinline__ void stage_rc(int b, int& R, int& C) { const int st = b / 1024, sb = b % 1024, swz = sb ^ (((sb >> 9) & 1) << 5); R = (st >> 1) * 16 + swz / 64; C = (st & 1) * 32 + (swz % 64) / 2; }
__host__ __device__ __forceinline__ int perm32(int rho) { const int n = rho >> 4, i = rho & 15; return 8 * (i >> 2) + 4 * n + (i & 3); }

struct Unit { int pm, pn; };
struct Gemm { const bf16_t* A; const bf16_t* Bt; int M, N, K; };

struct StaticOrder {
    int nM, nN, nwg, G, c;
    __host__ __device__ void init(int M, int N, int G_, int c_) { nM = M / BM; nN = N / BM; nwg = nM * nN; G = G_; c = c_; }
    __host__ __device__ bool next(int i, Unit& u) const {
        const long L = (long)i * G + c; if (L >= nwg) return false;
        int wgid = (int)L; { const int q = nwg / NXCD, r = nwg % NXCD, xcd = wgid % NXCD, off = wgid / NXCD; wgid = (xcd < r ? xcd * (q + 1) : r * (q + 1) + (xcd - r) * q) + off; }
        const int nig = WGM * nN, gid = wgid / nig, fm = gid * WGM, gsz = (nM - fm) < WGM ? (nM - fm) : WGM;
        u.pm = fm + ((wgid % nig) % gsz); u.pn = (wgid % nig) / gsz; return true;
    }
    __device__ __forceinline__ void a_ready(const Unit&) const {}
    __device__ __forceinline__ void done(const Unit&) const {}
};

__device__ __forceinline__ unsigned cvt_pk_bf16(float lo, float hi) { unsigned r; asm volatile("v_cvt_pk_bf16_f32 %0, %1, %2" : "=v"(r) : "v"(lo), "v"(hi)); return r; }
template <class Epi, class Sched, bool ALIGN_EPI = false, bool SP2 = false>
__device__ __forceinline__ void gemm_phase(PG8_LAS unsigned char* lds, const Gemm g, const Sched& S, const Epi& E) {
    const int tid = threadIdx.x, wid = __builtin_amdgcn_readfirstlane(tid >> 6), lane = tid & 63, wr = wid >> 2, wc = wid & 3, fr = lane & 15, fq = lane >> 4;
    const int K = g.K, nt = K / BK;
    unsigned voffA[2], voffB[2];
#pragma unroll
    for (int i = 0; i < 2; ++i) { int R, C; stage_rc(tid * 16 + i * 8192, R, C); const int Rb = Epi::PERM ? ((R & ~31) + perm32(R & 31)) : R;
        voffA[i] = (unsigned)(R * K + C) * 2u; voffB[i] = (unsigned)(Rb * K + C) * 2u; }
    const size_t kstep = (size_t)(BK * 2);
    const size_t hstep = (size_t)HALF * K * 2;
    const size_t tstep = 2 * hstep;
    const unsigned ldsw = (unsigned)wid * 1024u;
    const int aoff = lds_byte(wr * 64 + fr, fq * 8), boff = lds_byte(wc * 32 + fr, fq * 8);
#define PG8_SA(b, h) (((b) * 2 + (h)) * HTB)
#define PG8_SB(b, h) ((4 + (b) * 2 + (h)) * HTB)
#define PG8_STAGE(bufoff, gbase, voff) do { _Pragma("unroll") for (int _i = 0; _i < 2; ++_i) \
        __builtin_amdgcn_global_load_lds((const unsigned*)((const char*)(gbase) + (voff)[_i]), (PG8_LAS unsigned*)(lds + (bufoff) + ldsw + _i * 8192), 16, 0, 0); } while (0)
#define PG8_LDA(dst, b, h) do { _Pragma("unroll") for (int m = 0; m < 4; ++m) _Pragma("unroll") for (int k = 0; k < 2; ++k) dst[m][k] = *(const PG8_LAS bf16x8*)(lds + PG8_SA(b, h) + aoff + m * 2048 + k * 1024); } while (0)
#define PG8_LDB(dst, b, h) do { _Pragma("unroll") for (int n = 0; n < 2; ++n) _Pragma("unroll") for (int k = 0; k < 2; ++k) dst[n][k] = *(const PG8_LAS bf16x8*)(lds + PG8_SB(b, h) + boff + n * 2048 + k * 1024); } while (0)
#define PG8_MMA(ai, bj, At, Bt) do { __builtin_amdgcn_s_setprio(1); _Pragma("unroll") for (int m = 0; m < 4; ++m) _Pragma("unroll") for (int n = 0; n < 2; ++n) _Pragma("unroll") for (int k = 0; k < 2; ++k) \
        acc[ai][bj][m][n] = __builtin_amdgcn_mfma_f32_16x16x32_bf16(Bt[n][k], At[m][k], acc[ai][bj][m][n], 0, 0, 0); __builtin_amdgcn_s_setprio(0); } while (0)
#define PG8_WAIT_V(n) asm volatile("s_waitcnt vmcnt(" #n ")" ::: "memory")
#define PG8_WAIT_L(n) asm volatile("s_waitcnt lgkmcnt(" #n ")" ::: "memory")
#define PG8_BAR __builtin_amdgcn_s_barrier()
#define PG8_SCHED __builtin_amdgcn_sched_barrier(0)
    Unit cur, nxt; int ui = 0;
    if (!S.next(0, cur)) return;
    f32x4 acc[2][2][4][2];
#pragma unroll
    for (int a = 0; a < 2; ++a)
#pragma unroll
        for (int b = 0; b < 2; ++b)
#pragma unroll
            for (int m = 0; m < 4; ++m)
#pragma unroll
                for (int n = 0; n < 2; ++n) acc[a][b][m][n] = (f32x4){0.f, 0.f, 0.f, 0.f};
    bf16x8 At[4][2], B0[2][2], B1[2][2];
    const char* cA = (const char*)g.A + (size_t)cur.pm * tstep; const char* cB = (const char*)g.Bt + (size_t)cur.pn * tstep;
    S.a_ready(cur);
    if constexpr (SP2) {
        PG8_STAGE(PG8_SB(0, 0), cB, voffB); PG8_STAGE(PG8_SB(0, 1), cB + hstep, voffB); PG8_STAGE(PG8_SA(0, 0), cA, voffA); PG8_STAGE(PG8_SA(0, 1), cA + hstep, voffA);
        if (wr == 1) PG8_BAR;
        PG8_WAIT_V(2); PG8_BAR;
        PG8_STAGE(PG8_SB(1, 0), cB + kstep, voffB); PG8_STAGE(PG8_SA(1, 0), cA + kstep, voffA); PG8_STAGE(PG8_SB(1, 1), cB + hstep + kstep, voffB);
        PG8_WAIT_V(6); PG8_BAR;
    } else {
        PG8_STAGE(PG8_SB(0, 0), cB, voffB); PG8_STAGE(PG8_SA(0, 0), cA, voffA); PG8_STAGE(PG8_SB(0, 1), cB + hstep, voffB); PG8_STAGE(PG8_SA(0, 1), cA + hstep, voffA);
        if (wr == 1) PG8_BAR;
        PG8_WAIT_V(4); PG8_BAR;
        PG8_STAGE(PG8_SB(1, 0), cB + kstep, voffB); PG8_STAGE(PG8_SA(1, 0), cA + kstep, voffA); PG8_STAGE(PG8_SB(1, 1), cB + hstep + kstep, voffB);
        PG8_WAIT_V(6); PG8_BAR;
    }
    for (;;) {
        const bool has_next = S.next(ui + 1, nxt);
        const char* nA = has_next ? (const char*)g.A + (size_t)nxt.pm * tstep : cA; const char* nB = has_next ? (const char*)g.Bt + (size_t)nxt.pn * tstep : cB;
        for (int t = 0; t < nt; t += 2) {
            const bool last = (t == nt - 2);
            const char* a1 = cA + (size_t)(t + 1) * kstep;
            const char* a2 = last ? nA : cA + (size_t)(t + 2) * kstep; const char* b2 = last ? nB : cB + (size_t)(t + 2) * kstep;
            const char* a3 = a2 + kstep; const char* b3 = b2 + kstep;
            if (last && has_next) S.a_ready(nxt);
            if constexpr (SP2) {
            PG8_LDB(B0, 0, 0); PG8_LDB(B1, 0, 1); PG8_SCHED; PG8_LDA(At, 0, 0); PG8_STAGE(PG8_SA(1, 1), a1 + hstep, voffA);
            PG8_WAIT_V(8); PG8_WAIT_L(0); PG8_BAR; PG8_MMA(0, 0, At, B0); PG8_MMA(0, 1, At, B1); PG8_BAR; PG8_SCHED;
            PG8_LDA(At, 0, 1); PG8_STAGE(PG8_SB(0, 0), b2, voffB); PG8_STAGE(PG8_SB(0, 1), b2 + hstep, voffB); PG8_STAGE(PG8_SA(0, 0), a2, voffA);
            PG8_WAIT_V(8); PG8_WAIT_L(0); PG8_BAR; PG8_MMA(1, 0, At, B0); PG8_MMA(1, 1, At, B1); PG8_BAR; PG8_SCHED;
            PG8_LDB(B0, 1, 0); PG8_LDB(B1, 1, 1); PG8_SCHED; PG8_LDA(At, 1, 0); PG8_STAGE(PG8_SA(0, 1), a2 + hstep, voffA);
            PG8_WAIT_V(8); PG8_WAIT_L(0); PG8_BAR; PG8_MMA(0, 0, At, B0); PG8_MMA(0, 1, At, B1); PG8_BAR; PG8_SCHED;
            PG8_LDA(At, 1, 1); PG8_STAGE(PG8_SB(1, 0), b3, voffB); PG8_STAGE(PG8_SB(1, 1), b3 + hstep, voffB); PG8_STAGE(PG8_SA(1, 0), a3, voffA);
            PG8_WAIT_V(8); PG8_WAIT_L(0); PG8_BAR; PG8_MMA(1, 0, At, B0); PG8_MMA(1, 1, At, B1); PG8_BAR; PG8_SCHED;
            } else {
            PG8_LDB(B0, 0, 0); PG8_SCHED; PG8_LDA(At, 0, 0); PG8_STAGE(PG8_SA(1, 1), a1 + hstep, voffA);
            PG8_WAIT_L(8); PG8_BAR; PG8_WAIT_L(0); PG8_MMA(0, 0, At, B0); PG8_BAR; PG8_SCHED;
            PG8_LDB(B1, 0, 1); PG8_STAGE(PG8_SB(0, 0), b2, voffB);
            PG8_BAR; PG8_WAIT_L(0); PG8_MMA(0, 1, At, B1); PG8_BAR;
            PG8_LDA(At, 0, 1); PG8_STAGE(PG8_SA(0, 0), a2, voffA);
            PG8_BAR; PG8_WAIT_L(0); PG8_MMA(1, 0, At, B0); PG8_BAR; PG8_SCHED;
            PG8_STAGE(PG8_SB(0, 1), b2 + hstep, voffB);
            PG8_WAIT_V(6); PG8_BAR; PG8_MMA(1, 1, At, B1); PG8_BAR;
            PG8_LDB(B0, 1, 0); PG8_SCHED; PG8_LDA(At, 1, 0); PG8_STAGE(PG8_SA(0, 1), a2 + hstep, voffA);
            PG8_WAIT_L(8); PG8_BAR; PG8_WAIT_L(0); PG8_MMA(0, 0, At, B0); PG8_BAR; PG8_SCHED;
            PG8_LDB(B1, 1, 1); PG8_STAGE(PG8_SB(1, 0), b3, voffB);
            PG8_BAR; PG8_WAIT_L(0); PG8_MMA(0, 1, At, B1); PG8_BAR;
            PG8_LDA(At, 1, 1); PG8_STAGE(PG8_SA(1, 0), a3, voffA);
            PG8_BAR; PG8_WAIT_L(0); PG8_MMA(1, 0, At, B0); PG8_BAR; PG8_SCHED;
            PG8_STAGE(PG8_SB(1, 1), b3 + hstep, voffB);
            PG8_WAIT_V(6); PG8_BAR; PG8_MMA(1, 1, At, B1); PG8_BAR;
            }
        }
        if constexpr (ALIGN_EPI) { if (wr == 0) PG8_BAR; }
        if constexpr (!Epi::AFTER_DRAIN) { E(acc, cur, wr, wc, fr, fq); S.done(cur); }
        if (!has_next) break;
#pragma unroll
        for (int a = 0; a < 2; ++a)
#pragma unroll
            for (int b = 0; b < 2; ++b)
#pragma unroll
                for (int m = 0; m < 4; ++m)
#pragma unroll
                    for (int n = 0; n < 2; ++n) acc[a][b][m][n] = (f32x4){0.f, 0.f, 0.f, 0.f};
        cur = nxt; cA = nA; cB = nB; ++ui;
        if constexpr (ALIGN_EPI) { if (wr == 1) PG8_BAR; }
    }
    PG8_WAIT_V(0);
    if constexpr (!ALIGN_EPI) { if (wr == 0) PG8_BAR; }
    PG8_BAR;
    if constexpr (Epi::AFTER_DRAIN) { E.fused(acc, cur, wr, wc, fr, fq, lds, wid, lane); S.done(cur); }
#undef PG8_SA
#undef PG8_SB
#undef PG8_STAGE
#undef PG8_LDA
#undef PG8_LDB
#undef PG8_MMA
#undef PG8_WAIT_V
#undef PG8_WAIT_L
#undef PG8_BAR
#undef PG8_SCHED
}

template <int ACT  > struct EpiBf16 {
    static constexpr bool PERM = true, AFTER_DRAIN = false;
    bf16_t* O; int ldc; int pad;
    __device__ __forceinline__ void operator()(const f32x4 (&acc)[2][2][4][2], const Unit& u, int wr, int wc, int fr, int fq) const {
        const int row0 = u.pm * BM + wr * 64 + fr, col0 = u.pn * BM + wc * 32 + 8 * fq;
#pragma unroll
        for (int ai = 0; ai < 2; ++ai)
#pragma unroll
            for (int m = 0; m < 4; ++m) { bf16_t* rowp = O + (size_t)(row0 + ai * HALF + m * 16) * ldc + col0;
#pragma unroll
                for (int bj = 0; bj < 2; ++bj) { f32x4 v0 = acc[ai][bj][m][0], v1 = acc[ai][bj][m][1];
                    if (ACT == 1) {
#pragma unroll
                        for (int j = 0; j < 4; ++j) { float a = v0[j] > 0.f ? v0[j] : 0.f, b = v1[j] > 0.f ? v1[j] : 0.f; v0[j] = a * a; v1[j] = b * b; } }
                    u32x4 w; w.x = cvt_pk_bf16(v0[0], v0[1]); w.y = cvt_pk_bf16(v0[2], v0[3]); w.z = cvt_pk_bf16(v1[0], v1[1]); w.w = cvt_pk_bf16(v1[2], v1[3]);
                    *(u32x4*)(rowp + bj * HALF) = w; } }
    }
};
struct EpiF32 {
    static constexpr bool PERM = true, AFTER_DRAIN = false;
    float* O; int ldc; int pad;
    __device__ __forceinline__ void operator()(const f32x4 (&acc)[2][2][4][2], const Unit& u, int wr, int wc, int fr, int fq) const {
        const int row0 = u.pm * BM + wr * 64 + fr, col0 = u.pn * BM + wc * 32 + 8 * fq;
#pragma unroll
        for (int ai = 0; ai < 2; ++ai)
#pragma unroll
            for (int m = 0; m < 4; ++m) { float* rowp = O + (size_t)(row0 + ai * HALF + m * 16) * ldc + col0;
#pragma unroll
                for (int bj = 0; bj < 2; ++bj) { *(f32x4*)(rowp + bj * HALF) = acc[ai][bj][m][0]; *(f32x4*)(rowp + bj * HALF + 4) = acc[ai][bj][m][1]; } }
    }
};
}

#define LAS __attribute__((address_space(3)))

struct Params {
  const float *x, *c, *w_ada, *b_ada, *pre_mix_w, *post_mix_w, *w_in, *dn_conv_w, *dn_a_log, *dn_dt_bias,
      *dn_norm_w, *sc_conv_w, *w_out, *pre_ffn_w, *post_ffn_w, *w_ff1, *w_ff2;
  float* out;
  unsigned char* ws;
};

__device__ __forceinline__ bf16_t f2bf(float x) {
  unsigned u = __float_as_uint(x);
  u += 0x7fffu + ((u >> 16) & 1u);
  return (bf16_t)(u >> 16);
}
__device__ __forceinline__ float bf2f(bf16_t b) { return __uint_as_float(((unsigned)b) << 16); }
__device__ __forceinline__ unsigned pack2(float lo, float hi) { return (unsigned)f2bf(lo) | ((unsigned)f2bf(hi) << 16); }
__device__ __forceinline__ float bflo(unsigned u) { return __uint_as_float(u << 16); }
__device__ __forceinline__ float bfhi(unsigned u) { return __uint_as_float(u & 0xffff0000u); }
__device__ __forceinline__ float siluf(float x) { return x / (1.f + __expf(-x)); }
__device__ __forceinline__ float sigmoidf_(float x) { return 1.f / (1.f + __expf(-x)); }
__device__ __forceinline__ float softplusf_(float x) { return x > 20.f ? x : log1pf(expf(x)); }

__device__ __forceinline__ float wave_sum(float v) {
#pragma unroll
  for (int o = 32; o >= 1; o >>= 1) v += __shfl_xor(v, o);
  return v;
}

__device__ __forceinline__ f32x4 load_mod4(const Params& P, int b, int col) {
  const float* mp = (const float*)(P.ws + WS_MODP);
  f32x4 v = *(const f32x4*)(P.b_ada + col);
#pragma unroll
  for (int s = 0; s < MOD_KS; ++s) v += *(const f32x4*)(mp + ((size_t)s * NB + b) * 6144 + col);
  return v;
}

__device__ void phase_mod(const Params& P, int item, float* lds) {
  const int ks = item / 48, cg = item % 48, t = threadIdx.x, kq = t >> 7, cl = t & 127;
  float* sc = lds;
  float* red = lds + 2048;
  __syncthreads();
  for (int i = t; i < 8 * 256; i += 512) { int b = i >> 8, k = i & 255; sc[i] = siluf(P.c[b * D + ks * 256 + k]); }
  __syncthreads();
  float acc[8];
#pragma unroll
  for (int b = 0; b < 8; ++b) acc[b] = 0.f;
  const float* wp = P.w_ada + (size_t)(ks * 256 + kq * 64) * 6144 + cg * 128 + cl;
  for (int k = 0; k < 64; ++k) {
    float w = wp[(size_t)k * 6144];
#pragma unroll
    for (int b = 0; b < 8; ++b) acc[b] += sc[b * 256 + kq * 64 + k] * w;
  }
#pragma unroll
  for (int b = 0; b < 8; ++b) red[(kq * 8 + b) * 128 + cl] = acc[b];
  __syncthreads();
  float* mp = (float*)(P.ws + WS_MODP);
  for (int i = t; i < 8 * 128; i += 512) {
    int b = i >> 7, c2 = i & 127;
    float s = red[(0 * 8 + b) * 128 + c2] + red[(1 * 8 + b) * 128 + c2] + red[(2 * 8 + b) * 128 + c2] + red[(3 * 8 + b) * 128 + c2];
    mp[((size_t)ks * NB + b) * 6144 + cg * 128 + c2] = s;
  }
}


__device__ __forceinline__ void transpose_item(const float* W, int ldw, int K, bf16_t* WT, LAS float* scr, int k0, int n0d, int n0s, int lane) {
#pragma unroll 8
  for (int i = 0; i < 32; ++i) { const int kk = 2 * i + (lane >> 5); scr[kk * 33 + (lane & 31)] = W[(size_t)(k0 + kk) * ldw + n0s + (lane & 31)]; }
  asm volatile("s_waitcnt lgkmcnt(0)" ::: "memory");
  const int c = lane & 7;
#pragma unroll
  for (int j = 0; j < 4; ++j) { const int n = (lane >> 3) + 8 * j; const LAS float* sp = scr + (8 * c) * 33 + n;
    u32x4 o; o.x = pack2(sp[0 * 33], sp[1 * 33]); o.y = pack2(sp[2 * 33], sp[3 * 33]); o.z = pack2(sp[4 * 33], sp[5 * 33]); o.w = pack2(sp[6 * 33], sp[7 * 33]);
    *(u32x4*)(WT + (size_t)(n0d + n) * K + k0 + 8 * c) = o; }
  asm volatile("s_waitcnt lgkmcnt(0)" ::: "memory");
}
constexpr int CV_IN = 16 * 112, CV_OUT = 16 * 32, CV_FF1 = 16 * 128, CV_FF2 = 64 * 32, CV_ITEMS = CV_IN + CV_OUT + CV_FF1 + CV_FF2;
__device__ __forceinline__ void phase_convert(const Params& P, int gw, int ngw, LAS float* scr, int lane) {
  for (int it = gw; it < CV_ITEMS; it += ngw) {
    int r = it;
    if (r < CV_IN) { const int kb = r / 112, nb = r % 112, n0 = 32 * nb; transpose_item(P.w_in, DIN, D, (bf16_t*)(P.ws + WS_WT_IN), scr, 64 * kb, n0, n0 + (n0 >= 2048 ? 8 : 0), lane); continue; } r -= CV_IN;
    if (r < CV_OUT) { const int kb = r / 32, nb = r % 32; transpose_item(P.w_out, D, D, (bf16_t*)(P.ws + WS_WT_OUT), scr, 64 * kb, 32 * nb, 32 * nb, lane); continue; } r -= CV_OUT;
    if (r < CV_FF1) { const int kb = r / 128, nb = r % 128; transpose_item(P.w_ff1, DFF, D, (bf16_t*)(P.ws + WS_WT_FF1), scr, 64 * kb, 32 * nb, 32 * nb, lane); continue; } r -= CV_FF1;
    { const int kb = r / 32, nb = r % 32; transpose_item(P.w_ff2, D, DFF, (bf16_t*)(P.ws + WS_WT_FF2), scr, 64 * kb, 32 * nb, 32 * nb, lane); }
  }
}

__device__ void phase_prenorm(const Params& P, int bid, int nb, float* lds) {
  const int t = threadIdx.x, hf = t >> 8, u = t & 255, wv = t >> 6, lane = t & 63;
  const int rpb = M / nb, r0 = bid * rpb, b = r0 / SEQ;
  bf16_t* H = (bf16_t*)(P.ws + WS_H);
  float* G = (float*)(P.ws + WS_G);
  float* BETA = (float*)(P.ws + WS_BETA);
  f32x4 sh = load_mod4(P, b, 0 * D + 4 * u), sc = load_mod4(P, b, 1 * D + 4 * u);
  f32x4 wn = *(const f32x4*)(P.pre_mix_w + 4 * u);
  f32x4 mulv = wn * (sc + 1.0f);
  float wab[4][8];
#pragma unroll
  for (int kk = 0; kk < 4; ++kk) {
    f32x4 a = *(const f32x4*)(P.w_in + (size_t)(4 * u + kk) * DIN + 2048);
    f32x4 c = *(const f32x4*)(P.w_in + (size_t)(4 * u + kk) * DIN + 2052);
#pragma unroll
    for (int j = 0; j < 4; ++j) { wab[kk][j] = a[j]; wab[kk][4 + j] = c[j]; }
  }
  float* red_ss = lds;
  float* red_ab = lds + 16;
  __syncthreads();
  for (int it = 0; it < rpb / 2; ++it) {
    const int row = r0 + 2 * it + hf, par = it & 1;
    f32x4 xv = *(const f32x4*)(P.x + (size_t)row * D + 4 * u);
    float ss = xv[0] * xv[0] + xv[1] * xv[1] + xv[2] * xv[2] + xv[3] * xv[3];
    ss = wave_sum(ss);
    if (lane == 0) red_ss[par * 8 + wv] = ss;
    __syncthreads();
    float tot = red_ss[par * 8 + hf * 4 + 0] + red_ss[par * 8 + hf * 4 + 1] + red_ss[par * 8 + hf * 4 + 2] + red_ss[par * 8 + hf * 4 + 3];
    float rstd = rsqrtf(tot * (1.0f / D) + EPS);
    f32x4 hv = xv * rstd * mulv + sh;
    u32x2 pk; pk[0] = pack2(hv[0], hv[1]); pk[1] = pack2(hv[2], hv[3]);
    *(u32x2*)(H + (size_t)row * D + 4 * u) = pk;
    float pa[8];
#pragma unroll
    for (int j = 0; j < 8; ++j) pa[j] = hv[0] * wab[0][j] + hv[1] * wab[1][j] + hv[2] * wab[2][j] + hv[3] * wab[3][j];
#pragma unroll
    for (int j = 0; j < 8; ++j) pa[j] = wave_sum(pa[j]);
    if (lane == 0) {
#pragma unroll
      for (int j = 0; j < 8; ++j) red_ab[(par * 8 + wv) * 8 + j] = pa[j];
    }
    __syncthreads();
    if (u < 8) {
      float v = red_ab[(par * 8 + hf * 4 + 0) * 8 + u] + red_ab[(par * 8 + hf * 4 + 1) * 8 + u] + red_ab[(par * 8 + hf * 4 + 2) * 8 + u] + red_ab[(par * 8 + hf * 4 + 3) * 8 + u];
      if (u < 4) {
        float g = -expf(P.dn_a_log[u]) * softplusf_(v + P.dn_dt_bias[u]);
        G[(size_t)row * 4 + u] = g;
      } else {
        BETA[(size_t)row * 4 + (u - 4)] = sigmoidf_(v);
      }
    }
  }
}

__device__ void phase_dn_naive(const Params& P, int bh, float* lds) {
  const int b = bh >> 2, h = bh & 3, t = threadIdx.x, e = t & 127, qd = t >> 7, wv = t >> 6, lane = t & 63;
  const bf16_t* PROJ = (const bf16_t*)(P.ws + WS_PROJ);
  const float* G = (const float*)(P.ws + WS_G);
  const float* BETA = (const float*)(P.ws + WS_BETA);
  bf16_t* O = (bf16_t*)(P.ws + WS_O);
  float *sq = lds, *sk = lds + 128, *sv = lds + 256, *part = lds + 384, *red = lds + 896;
  float s[32];
#pragma unroll
  for (int i = 0; i < 32; ++i) s[i] = 0.f;
  const int col = (qd == 0 ? OFF_Q : (qd == 1 ? OFF_K : OFF_V)) + h * HD + e;
  float w[4];
#pragma unroll
  for (int j = 0; j < 4; ++j) w[j] = P.dn_conv_w[j * 1536 + col];
  float r0 = 0.f, r1 = 0.f, r2 = 0.f;
  __syncthreads();
  for (int tk = 0; tk < SEQ; ++tk) {
    const size_t row = (size_t)b * SEQ + tk;
    const float xa = bf2f(PROJ[row * DP + col]);
    float c = w[0] * r0 + w[1] * r1 + w[2] * r2 + w[3] * xa;
    r0 = r1; r1 = r2; r2 = xa;
    c = siluf(c);
    const float ssq = wave_sum(c * c);
    if (lane == 0) red[wv] = ssq;
    __syncthreads();
    const float tot = red[2 * qd] + red[2 * qd + 1];
    if (qd == 0) sq[e] = c * rsqrtf(tot + EPS) * 0.08838834764831845f;
    else if (qd == 1) sk[e] = c * rsqrtf(tot + EPS);
    else if (qd == 2) sv[e] = c;
    __syncthreads();
    const float g = G[row * 4 + h], beta = BETA[row * 4 + h], eg = expf(g);
    float ks = 0.f;
#pragma unroll
    for (int i = 0; i < 32; ++i) { s[i] *= eg; ks += sk[qd * 32 + i] * s[i]; }
    part[qd * 128 + e] = ks;
    __syncthreads();
    const float delta = beta * (sv[e] - (part[e] + part[128 + e] + part[256 + e] + part[384 + e]));
    float op = 0.f;
#pragma unroll
    for (int i = 0; i < 32; ++i) { s[i] += sk[qd * 32 + i] * delta; op += sq[qd * 32 + i] * s[i]; }
    __syncthreads();
    part[qd * 128 + e] = op;
    __syncthreads();
    if (qd == 0) O[row * 512 + h * HD + e] = f2bf(part[e] + part[128 + e] + part[256 + e] + part[384 + e]);
  }
}

__device__ void phase_gate_mix(const Params& P, int bid, int nb) {
  const int t = threadIdx.x, hf = t >> 8, u = t & 255;
  const bf16_t* PROJ = (const bf16_t*)(P.ws + WS_PROJ);
  const bf16_t* O = (const bf16_t*)(P.ws + WS_O);
  bf16_t* MIX = (bf16_t*)(P.ws + WS_MIX);
  for (int rp = bid; rp < M / 2; rp += nb) {
    const int row = 2 * rp + hf, tk = row % SEQ;
    if (u < 128) {
      const int col = 4 * u;
      u32x2 ov = *(const u32x2*)(O + (size_t)row * 512 + col);
      float o0 = bflo(ov[0]), o1 = bfhi(ov[0]), o2 = bflo(ov[1]), o3 = bfhi(ov[1]);
      float ss = o0 * o0 + o1 * o1 + o2 * o2 + o3 * o3;
#pragma unroll
      for (int o = 16; o >= 1; o >>= 1) ss += __shfl_xor(ss, o);
      const float rstd = rsqrtf(ss * (1.0f / HD) + EPS);
      u32x2 zv = *(const u32x2*)(PROJ + (size_t)row * DP + OFF_Z + col);
      f32x4 nw = *(const f32x4*)(P.dn_norm_w + (col & 127));
      float r0 = o0 * rstd * nw[0] * siluf(bflo(zv[0])), r1 = o1 * rstd * nw[1] * siluf(bfhi(zv[0]));
      float r2 = o2 * rstd * nw[2] * siluf(bflo(zv[1])), r3 = o3 * rstd * nw[3] * siluf(bfhi(zv[1]));
      u32x2 pk; pk[0] = pack2(r0, r1); pk[1] = pack2(r2, r3);
      *(u32x2*)(MIX + (size_t)row * D + col) = pk;
    } else {
      const int col = 4 * (u - 128);
      float acc[4] = {0.f, 0.f, 0.f, 0.f};
#pragma unroll
      for (int j = 0; j < 3; ++j) {
        const int dt = 2 - j;
        if (tk - dt >= 0) {
          u32x2 cv = *(const u32x2*)(PROJ + (size_t)(row - dt) * DP + OFF_SC + col);
          u32x2 hv = *(const u32x2*)(PROJ + (size_t)(row - dt) * DP + OFF_SH + col);
          f32x4 w = *(const f32x4*)(P.sc_conv_w + j * 512 + col);
          acc[0] += w[0] * bflo(cv[0]) * bflo(hv[0]); acc[1] += w[1] * bfhi(cv[0]) * bfhi(hv[0]);
          acc[2] += w[2] * bflo(cv[1]) * bflo(hv[1]); acc[3] += w[3] * bfhi(cv[1]) * bfhi(hv[1]);
        }
      }
      u32x2 bv = *(const u32x2*)(PROJ + (size_t)row * DP + OFF_SB + col);
      u32x2 pk; pk[0] = pack2(acc[0] * bflo(bv[0]), acc[1] * bfhi(bv[0])); pk[1] = pack2(acc[2] * bflo(bv[1]), acc[3] * bfhi(bv[1]));
      *(u32x2*)(MIX + (size_t)row * D + 512 + col) = pk;
    }
  }
}

__device__ void phase_post1(const Params& P, int bid, int nb, float* lds) {
  const int t = threadIdx.x, hf = t >> 8, u = t & 255, wv = t >> 6, lane = t & 63;
  const int rpb = M / nb, r0 = bid * rpb, b = r0 / SEQ;
  const float* Y = (const float*)(P.ws + WS_Y);
  bf16_t* H2 = (bf16_t*)(P.ws + WS_H2);
  f32x4 gm = load_mod4(P, b, 2 * D + 4 * u), shf = load_mod4(P, b, 3 * D + 4 * u), scf = load_mod4(P, b, 4 * D + 4 * u);
  f32x4 wpost = *(const f32x4*)(P.post_mix_w + 4 * u), wpre = *(const f32x4*)(P.pre_ffn_w + 4 * u);
  f32x4 m1 = gm * wpost, m2 = wpre * (scf + 1.0f);
  float* red = lds;
  __syncthreads();
  for (int it = 0; it < rpb / 2; ++it) {
    const int row = r0 + 2 * it + hf, par = it & 1;
    f32x4 yv = *(const f32x4*)(Y + (size_t)row * D + 4 * u);
    f32x4 xv = *(const f32x4*)(P.x + (size_t)row * D + 4 * u);
    float ss = wave_sum(yv[0] * yv[0] + yv[1] * yv[1] + yv[2] * yv[2] + yv[3] * yv[3]);
    if (lane == 0) red[(par * 2 + 0) * 8 + wv] = ss;
    __syncthreads();
    const float* rr = red + (par * 2 + 0) * 8 + hf * 4;
    float rstd = rsqrtf((rr[0] + rr[1] + rr[2] + rr[3]) * (1.0f / D) + EPS);
    f32x4 x1 = xv + yv * rstd * m1;
    *(f32x4*)(P.out + (size_t)row * D + 4 * u) = x1;
    float ss2 = wave_sum(x1[0] * x1[0] + x1[1] * x1[1] + x1[2] * x1[2] + x1[3] * x1[3]);
    if (lane == 0) red[(par * 2 + 1) * 8 + wv] = ss2;
    __syncthreads();
    const float* rr2 = red + (par * 2 + 1) * 8 + hf * 4;
    float rstd2 = rsqrtf((rr2[0] + rr2[1] + rr2[2] + rr2[3]) * (1.0f / D) + EPS);
    f32x4 hv = x1 * rstd2 * m2 + shf;
    u32x2 pk; pk[0] = pack2(hv[0], hv[1]); pk[1] = pack2(hv[2], hv[3]);
    *(u32x2*)(H2 + (size_t)row * D + 4 * u) = pk;
  }
}

__device__ void phase_final(const Params& P, int bid, int nb, float* lds) {
  const int t = threadIdx.x, hf = t >> 8, u = t & 255, wv = t >> 6, lane = t & 63;
  const int rpb = M / nb, r0 = bid * rpb, b = r0 / SEQ;
  const float* Y2 = (const float*)(P.ws + WS_Y2);
  f32x4 gf = load_mod4(P, b, 5 * D + 4 * u);
  f32x4 wpost = *(const f32x4*)(P.post_ffn_w + 4 * u);
  f32x4 m1 = gf * wpost;
  float* red = lds;
  __syncthreads();
  for (int it = 0; it < rpb / 2; ++it) {
    const int row = r0 + 2 * it + hf, par = it & 1;
    f32x4 yv = *(const f32x4*)(Y2 + (size_t)row * D + 4 * u);
    f32x4 xv = *(const f32x4*)(P.out + (size_t)row * D + 4 * u);
    float ss = wave_sum(yv[0] * yv[0] + yv[1] * yv[1] + yv[2] * yv[2] + yv[3] * yv[3]);
    if (lane == 0) red[par * 8 + wv] = ss;
    __syncthreads();
    const float* rr = red + par * 8 + hf * 4;
    float rstd = rsqrtf((rr[0] + rr[1] + rr[2] + rr[3]) * (1.0f / D) + EPS);
    *(f32x4*)(P.out + (size_t)row * D + 4 * u) = xv + yv * rstd * m1;
  }
}

__global__ void __launch_bounds__(512, 2) k_mega(Params P) {
  __shared__ __attribute__((aligned(16))) unsigned char lds[pg8::STAGE_BYTES];
  cg::grid_group grid = cg::this_grid();
  const int bid = blockIdx.x, nb = gridDim.x, wv = threadIdx.x >> 6, lane = threadIdx.x & 63;
  unsigned char* ws = P.ws;
  for (int it = bid; it < 192; it += nb) phase_mod(P, it, (float*)lds);
  __syncthreads();
  phase_convert(P, bid * 8 + wv, nb * 8, (LAS float*)lds + wv * 2112, lane);
  grid.sync();
  phase_prenorm(P, bid, nb, (float*)lds);
  grid.sync();
  { pg8::Gemm g{(const bf16_t*)(ws + WS_H), (const bf16_t*)(ws + WS_WT_IN), M, DP, D}; pg8::StaticOrder S; S.init(M, DP, nb, bid);
    pg8::EpiBf16<0> E{(bf16_t*)(ws + WS_PROJ), DP, 0};
    pg8::gemm_phase<pg8::EpiBf16<0>, pg8::StaticOrder, true, true>((PG8_LAS unsigned char*)lds, g, S, E); }
  grid.sync();
  for (int bh = bid; bh < 32; bh += nb) phase_dn_naive(P, bh, (float*)lds);
  grid.sync();
  phase_gate_mix(P, bid, nb);
  grid.sync();
  { pg8::Gemm g{(const bf16_t*)(ws + WS_MIX), (const bf16_t*)(ws + WS_WT_OUT), M, D, D}; pg8::StaticOrder S; S.init(M, D, nb, bid);
    pg8::EpiF32 E{(float*)(ws + WS_Y), D, 0};
    pg8::gemm_phase<pg8::EpiF32, pg8::StaticOrder, true, true>((PG8_LAS unsigned char*)lds, g, S, E); }
  grid.sync();
  phase_post1(P, bid, nb, (float*)lds);
  grid.sync();
  { pg8::Gemm g{(const bf16_t*)(ws + WS_H2), (const bf16_t*)(ws + WS_WT_FF1), M, DFF, D}; pg8::StaticOrder S; S.init(M, DFF, nb, bid);
    pg8::EpiBf16<1> E{(bf16_t*)(ws + WS_HID), DFF, 0};
    pg8::gemm_phase<pg8::EpiBf16<1>, pg8::StaticOrder, true, true>((PG8_LAS unsigned char*)lds, g, S, E); }
  grid.sync();
  { pg8::Gemm g{(const bf16_t*)(ws + WS_HID), (const bf16_t*)(ws + WS_WT_FF2), M, D, DFF}; pg8::StaticOrder S; S.init(M, D, nb, bid);
    pg8::EpiF32 E{(float*)(ws + WS_Y2), D, 0};
    pg8::gemm_phase<pg8::EpiF32, pg8::StaticOrder, true, true>((PG8_LAS unsigned char*)lds, g, S, E); }
  grid.sync();
  phase_final(P, bid, nb, (float*)lds);
}

extern "C" void kernel_launch(void* const* d_in, const int* in_sizes, int n_in, void* d_out, int out_size, void* d_ws, size_t ws_size,
                              hipStream_t stream) {
  static int grid_blocks = 0;
  if (!grid_blocks) {
    int dev = 0, cus = 0, per_cu = 0;
    hipGetDevice(&dev);
    hipDeviceGetAttribute(&cus, hipDeviceAttributeMultiprocessorCount, dev);
    hipOccupancyMaxActiveBlocksPerMultiprocessor(&per_cu, (const void*)k_mega, 512, 0);
    if (per_cu < 1) per_cu = 1;
    grid_blocks = cus * per_cu;
    if (grid_blocks > 256) grid_blocks = 256;
    if (grid_blocks < 256) { int g = 1; while (g * 2 <= grid_blocks) g *= 2; grid_blocks = g; }
  }
  Params P{};
  P.x = (const float*)d_in[0]; P.c = (const float*)d_in[1]; P.w_ada = (const float*)d_in[2]; P.b_ada = (const float*)d_in[3];
  P.pre_mix_w = (const float*)d_in[4]; P.post_mix_w = (const float*)d_in[5]; P.w_in = (const float*)d_in[6];
  P.dn_conv_w = (const float*)d_in[7]; P.dn_a_log = (const float*)d_in[8]; P.dn_dt_bias = (const float*)d_in[9];
  P.dn_norm_w = (const float*)d_in[10]; P.sc_conv_w = (const float*)d_in[11]; P.w_out = (const float*)d_in[12];
  P.pre_ffn_w = (const float*)d_in[13]; P.post_ffn_w = (const float*)d_in[14]; P.w_ff1 = (const float*)d_in[15];
  P.w_ff2 = (const float*)d_in[16];
  P.out = (float*)d_out; P.ws = (unsigned char*)d_ws;
  void* args[] = {&P};
  hipError_t e = hipLaunchCooperativeKernel((const void*)k_mega, dim3(grid_blocks), dim3(512), args, 0, stream);
  if (e != hipSuccess) fprintf(stderr, "cooperative launch failed: %s (grid %d)\n", hipGetErrorString(e), grid_blocks);
}
```

```cpp
#include <hip/hip_runtime.h>
#include <hip/hip_bf16.h>
#include <hip/hip_cooperative_groups.h>
#include <stdint.h>
#include <cstdio>
namespace cg = cooperative_groups;

typedef unsigned short bf16_t;
typedef float f32x4 __attribute__((ext_vector_type(4)));
typedef unsigned u32x2 __attribute__((ext_vector_type(2)));
typedef unsigned u32x4 __attribute__((ext_vector_type(4)));

constexpr int D = 1024, NB = 8, SEQ = 2048, M = NB * SEQ, DIN = 3592, DP = 3584, DFF = 4096;
constexpr int NH = 4, HD = 128;
constexpr float EPS = 1e-6f;
constexpr int OFF_Q = 0, OFF_K = 512, OFF_V = 1024, OFF_Z = 1536, OFF_SB = 2048, OFF_SC = 2560, OFF_SH = 3072;
constexpr int MOD_KS = 4;

constexpr size_t MiB = 1ull << 20;
constexpr size_t WS_WT_IN = 0, WS_WT_OUT = 7 * MiB, WS_WT_FF1 = 9 * MiB, WS_WT_FF2 = 17 * MiB;
constexpr size_t WS_MODP = 25 * MiB;
constexpr size_t WS_G = 25 * MiB + 768 * 1024;
constexpr size_t WS_BETA = 26 * MiB;
constexpr size_t WS_PROJ = 27 * MiB;
constexpr size_t WS_H = 139 * MiB;
constexpr size_t WS_GL = 26 * MiB + 256 * 1024;
constexpr size_t WS_QG = 139 * MiB;
constexpr size_t WS_KD = 155 * MiB;
constexpr size_t WS_WN = 171 * MiB;
constexpr size_t WS_ATT = 187 * MiB;
constexpr size_t WS_U = 195 * MiB;
constexpr size_t WS_O = 227 * MiB;
constexpr size_t WS_MIX = 139 * MiB;
constexpr size_t WS_Y = 27 * MiB;
constexpr size_t WS_HID = 27 * MiB;
constexpr size_t WS_H2 = 160 * MiB;
constexpr size_t WS_Y2 = 192 * MiB;

namespace pg8 {
#define PG8_LAS __attribute__((address_space(3)))
typedef unsigned short bf16_t;
typedef short bf16x8 __attribute__((ext_vector_type(8)));
typedef float f32x4 __attribute__((ext_vector_type(4)));
typedef unsigned u32x4 __attribute__((ext_vector_type(4)));
constexpr int BM = 256, BK = 64, HALF = 128, HTB = HALF * BK * 2  , STAGE_BYTES = 8 * HTB, NXCD = 8, WGM = 8;

__host__ __device__ __forceinline__ int lds_byte(int r, int c) { const int st = (r >> 4) * 2 + (c >> 5), rr = r & 15, cc = c & 31, ob = rr * 64 + cc * 2; return st * 1024 + (ob ^ (((ob >> 9) & 1) << 5)); }
__host__ __device__ __forceinline__ void stage_rc(int b, int& R, int& C) { const int st = b / 1024, sb = b % 1024, swz = sb ^ (((sb >> 9) & 1) << 5); R = (st >> 1) * 16 + swz / 64; C = (st & 1) * 32 + (swz % 64) / 2; }
__host__ __device__ __forceinline__ int perm32(int rho) { const int n = rho >> 4, i = rho & 15; return 8 * (i >> 2) + 4 * n + (i & 3); }

struct Unit { int pm, pn; };
struct Gemm { const bf16_t* A; const bf16_t* Bt; int M, N, K; };

struct StaticOrder {
    int nM, nN, nwg, G, c;
    __host__ __device__ void init(int M, int N, int G_, int c_) { nM = M / BM; nN = N / BM; nwg = nM * nN; G = G_; c = c_; }
    __host__ __device__ bool next(int i, Unit& u) const {
        const long L = (long)i * G + c; if (L >= nwg) return false;
        int wgid = (int)L; { const int q = nwg / NXCD, r = nwg % NXCD, xcd = wgid % NXCD, off = wgid / NXCD; wgid = (xcd < r ? xcd * (q + 1) : r * (q + 1) + (xcd - r) * q) + off; }
        const int nig = WGM * nN, gid = wgid / nig, fm = gid * WGM, gsz = (nM - fm) < WGM ? (nM - fm) : WGM;
        u.pm = fm + ((wgid % nig) % gsz); u.pn = (wgid % nig) / gsz; return true;
    }
    __device__ __forceinline__ void a_ready(const Unit&) const {}
    __device__ __forceinline__ void done(const Unit&) const {}
};

__device__ __forceinline__ unsigned cvt_pk_bf16(float lo, float hi) { unsigned r; asm volatile("v_cvt_pk_bf16_f32 %0, %1, %2" : "=v"(r) : "v"(lo), "v"(hi)); return r; }
template <class Epi, class Sched, bool ALIGN_EPI = false, bool SP2 = false>
__device__ __forceinline__ void gemm_phase(PG8_LAS unsigned char* lds, const Gemm g, const Sched& S, const Epi& E) {
    int tid_ = threadIdx.x; asm volatile("" : "+v"(tid_));
    const int tid = tid_, wid = __builtin_amdgcn_readfirstlane(tid >> 6), lane = tid & 63, wr = wid >> 2, wc = wid & 3, fr = lane & 15, fq = lane >> 4;
    const int K = g.K, nt = K / BK;
    unsigned voffA[2], voffB[2];
#pragma unroll
    for (int i = 0; i < 2; ++i) { int R, C; stage_rc(tid * 16 + i * 8192, R, C); const int Rb = Epi::PERM ? ((R & ~31) + perm32(R & 31)) : R;
        voffA[i] = (unsigned)(R * K + C) * 2u; voffB[i] = (unsigned)(Rb * K + C) * 2u; }
    const size_t kstep = (size_t)(BK * 2);
    const size_t hstep = (size_t)HALF * K * 2;
    const size_t tstep = 2 * hstep;
    const unsigned ldsw = (unsigned)wid * 1024u;
    const int aoff = lds_byte(wr * 64 + fr, fq * 8), boff = lds_byte(wc * 32 + fr, fq * 8);
#define PG8_SA(b, h) (((b) * 2 + (h)) * HTB)
#define PG8_SB(b, h) ((4 + (b) * 2 + (h)) * HTB)
#define PG8_STAGE(bufoff, gbase, voff) do { _Pragma("unroll") for (int _i = 0; _i < 2; ++_i) \
        __builtin_amdgcn_global_load_lds((const unsigned*)((const char*)(gbase) + (voff)[_i]), (PG8_LAS unsigned*)(lds + (bufoff) + ldsw + _i * 8192), 16, 0, 0); } while (0)
#define PG8_LDA(dst, b, h) do { _Pragma("unroll") for (int m = 0; m < 4; ++m) _Pragma("unroll") for (int k = 0; k < 2; ++k) dst[m][k] = *(const PG8_LAS bf16x8*)(lds + PG8_SA(b, h) + aoff + m * 2048 + k * 1024); } while (0)
#define PG8_LDB(dst, b, h) do { _Pragma("unroll") for (int n = 0; n < 2; ++n) _Pragma("unroll") for (int k = 0; k < 2; ++k) dst[n][k] = *(const PG8_LAS bf16x8*)(lds + PG8_SB(b, h) + boff + n * 2048 + k * 1024); } while (0)
#define PG8_MMA(ai, bj, At, Bt) do { __builtin_amdgcn_s_setprio(1); _Pragma("unroll") for (int m = 0; m < 4; ++m) _Pragma("unroll") for (int n = 0; n < 2; ++n) _Pragma("unroll") for (int k = 0; k < 2; ++k) \
        acc[ai][bj][m][n] = __builtin_amdgcn_mfma_f32_16x16x32_bf16(Bt[n][k], At[m][k], acc[ai][bj][m][n], 0, 0, 0); __builtin_amdgcn_s_setprio(0); } while (0)
#define PG8_WAIT_V(n) asm volatile("s_waitcnt vmcnt(" #n ")" ::: "memory")
#define PG8_WAIT_L(n) asm volatile("s_waitcnt lgkmcnt(" #n ")" ::: "memory")
#define PG8_BAR __builtin_amdgcn_s_barrier()
#define PG8_SCHED __builtin_amdgcn_sched_barrier(0)
    Unit cur, nxt; int ui = 0;
    if (!S.next(0, cur)) return;
    f32x4 acc[2][2][4][2];
#pragma unroll
    for (int a = 0; a < 2; ++a)
#pragma unroll
        for (int b = 0; b < 2; ++b)
#pragma unroll
            for (int m = 0; m < 4; ++m)
#pragma unroll
                for (int n = 0; n < 2; ++n) acc[a][b][m][n] = (f32x4){0.f, 0.f, 0.f, 0.f};
    bf16x8 At[4][2], B0[2][2], B1[2][2];
    const char* cA = (const char*)g.A + (size_t)cur.pm * tstep; const char* cB = (const char*)g.Bt + (size_t)cur.pn * tstep;
    S.a_ready(cur);
    if constexpr (SP2) {
        PG8_STAGE(PG8_SB(0, 0), cB, voffB); PG8_STAGE(PG8_SB(0, 1), cB + hstep, voffB); PG8_STAGE(PG8_SA(0, 0), cA, voffA); PG8_STAGE(PG8_SA(0, 1), cA + hstep, voffA);
        if (wr == 1) PG8_BAR;
        PG8_WAIT_V(2); PG8_BAR;
        PG8_STAGE(PG8_SB(1, 0), cB + kstep, voffB); PG8_STAGE(PG8_SA(1, 0), cA + kstep, voffA); PG8_STAGE(PG8_SB(1, 1), cB + hstep + kstep, voffB);
        PG8_WAIT_V(6); PG8_BAR;
    } else {
        PG8_STAGE(PG8_SB(0, 0), cB, voffB); PG8_STAGE(PG8_SA(0, 0), cA, voffA); PG8_STAGE(PG8_SB(0, 1), cB + hstep, voffB); PG8_STAGE(PG8_SA(0, 1), cA + hstep, voffA);
        if (wr == 1) PG8_BAR;
        PG8_WAIT_V(4); PG8_BAR;
        PG8_STAGE(PG8_SB(1, 0), cB + kstep, voffB); PG8_STAGE(PG8_SA(1, 0), cA + kstep, voffA); PG8_STAGE(PG8_SB(1, 1), cB + hstep + kstep, voffB);
        PG8_WAIT_V(6); PG8_BAR;
    }
    for (;;) {
        const bool has_next = S.next(ui + 1, nxt);
        const char* nA = has_next ? (const char*)g.A + (size_t)nxt.pm * tstep : cA; const char* nB = has_next ? (const char*)g.Bt + (size_t)nxt.pn * tstep : cB;
        for (int t = 0; t < nt; t += 2) {
            const bool last = (t == nt - 2);
            const char* a1 = cA + (size_t)(t + 1) * kstep;
            const char* a2 = last ? nA : cA + (size_t)(t + 2) * kstep; const char* b2 = last ? nB : cB + (size_t)(t + 2) * kstep;
            const char* a3 = a2 + kstep; const char* b3 = b2 + kstep;
            if (last && has_next) S.a_ready(nxt);
            if constexpr (SP2) {
            PG8_LDB(B0, 0, 0); PG8_LDB(B1, 0, 1); PG8_SCHED; PG8_LDA(At, 0, 0); PG8_STAGE(PG8_SA(1, 1), a1 + hstep, voffA);
            PG8_WAIT_V(8); PG8_WAIT_L(0); PG8_BAR; PG8_MMA(0, 0, At, B0); PG8_MMA(0, 1, At, B1); PG8_BAR; PG8_SCHED;
            PG8_LDA(At, 0, 1); PG8_STAGE(PG8_SB(0, 0), b2, voffB); PG8_STAGE(PG8_SB(0, 1), b2 + hstep, voffB); PG8_STAGE(PG8_SA(0, 0), a2, voffA);
            PG8_WAIT_V(8); PG8_WAIT_L(0); PG8_BAR; PG8_MMA(1, 0, At, B0); PG8_MMA(1, 1, At, B1); PG8_BAR; PG8_SCHED;
            PG8_LDB(B0, 1, 0); PG8_LDB(B1, 1, 1); PG8_SCHED; PG8_LDA(At, 1, 0); PG8_STAGE(PG8_SA(0, 1), a2 + hstep, voffA);
            PG8_WAIT_V(8); PG8_WAIT_L(0); PG8_BAR; PG8_MMA(0, 0, At, B0); PG8_MMA(0, 1, At, B1); PG8_BAR; PG8_SCHED;
            PG8_LDA(At, 1, 1); PG8_STAGE(PG8_SB(1, 0), b3, voffB); PG8_STAGE(PG8_SB(1, 1), b3 + hstep, voffB); PG8_STAGE(PG8_SA(1, 0), a3, voffA);
            PG8_WAIT_V(8); PG8_WAIT_L(0); PG8_BAR; PG8_MMA(1, 0, At, B0); PG8_MMA(1, 1, At, B1); PG8_BAR; PG8_SCHED;
            } else {
            PG8_LDB(B0, 0, 0); PG8_SCHED; PG8_LDA(At, 0, 0); PG8_STAGE(PG8_SA(1, 1), a1 + hstep, voffA);
            PG8_WAIT_L(8); PG8_BAR; PG8_WAIT_L(0); PG8_MMA(0, 0, At, B0); PG8_BAR; PG8_SCHED;
            PG8_LDB(B1, 0, 1); PG8_STAGE(PG8_SB(0, 0), b2, voffB);
            PG8_BAR; PG8_WAIT_L(0); PG8_MMA(0, 1, At, B1); PG8_BAR;
            PG8_LDA(At, 0, 1); PG8_STAGE(PG8_SA(0, 0), a2, voffA);
            PG8_BAR; PG8_WAIT_L(0); PG8_MMA(1, 0, At, B0); PG8_BAR; PG8_SCHED;
            PG8_STAGE(PG8_SB(0, 1), b2 + hstep, voffB);
            PG8_WAIT_V(6); PG8_BAR; PG8_MMA(1, 1, At, B1); PG8_BAR;
            PG8_LDB(B0, 1, 0); PG8_SCHED; PG8_LDA(At, 1, 0); PG8_STAGE(PG8_SA(0, 1), a2 + hstep, voffA);
            PG8_WAIT_L(8); PG8_BAR; PG8_WAIT_L(0); PG8_MMA(0, 0, At, B0); PG8_BAR; PG8_SCHED;
            PG8_LDB(B1, 1, 1); PG8_STAGE(PG8_SB(1, 0), b3, voffB);
            PG8_BAR; PG8_WAIT_L(0); PG8_MMA(0, 1, At, B1); PG8_BAR;
            PG8_LDA(At, 1, 1); PG8_STAGE(PG8_SA(1, 0), a3, voffA);
            PG8_BAR; PG8_WAIT_L(0); PG8_MMA(1, 0, At, B0); PG8_BAR; PG8_SCHED;
            PG8_STAGE(PG8_SB(1, 1), b3 + hstep, voffB);
            PG8_WAIT_V(6); PG8_BAR; PG8_MMA(1, 1, At, B1); PG8_BAR;
            }
        }
        if constexpr (ALIGN_EPI) { if (wr == 0) PG8_BAR; }
        if constexpr (!Epi::AFTER_DRAIN) { E(acc, cur, wr, wc, fr, fq); S.done(cur); }
        if (!has_next) break;
#pragma unroll
        for (int a = 0; a < 2; ++a)
#pragma unroll
            for (int b = 0; b < 2; ++b)
#pragma unroll
                for (int m = 0; m < 4; ++m)
#pragma unroll
                    for (int n = 0; n < 2; ++n) acc[a][b][m][n] = (f32x4){0.f, 0.f, 0.f, 0.f};
        cur = nxt; cA = nA; cB = nB; ++ui;
        if constexpr (ALIGN_EPI) { if (wr == 1) PG8_BAR; }
    }
    PG8_WAIT_V(0);
    if constexpr (!ALIGN_EPI) { if (wr == 0) PG8_BAR; }
    PG8_BAR;
    if constexpr (Epi::AFTER_DRAIN) { E.fused(acc, cur, wr, wc, fr, fq, lds, wid, lane); S.done(cur); }
#undef PG8_SA
#undef PG8_SB
#undef PG8_STAGE
#undef PG8_LDA
#undef PG8_LDB
#undef PG8_MMA
#undef PG8_WAIT_V
#undef PG8_WAIT_L
#undef PG8_BAR
#undef PG8_SCHED
}

template <int ACT  > struct EpiBf16 {
    static constexpr bool PERM = true, AFTER_DRAIN = false;
    bf16_t* O; int ldc; int pad;
    __device__ __forceinline__ void operator()(const f32x4 (&acc)[2][2][4][2], const Unit& u, int wr, int wc, int fr, int fq) const {
        const int row0 = u.pm * BM + wr * 64 + fr, col0 = u.pn * BM + wc * 32 + 8 * fq;
#pragma unroll
        for (int ai = 0; ai < 2; ++ai)
#pragma unroll
            for (int m = 0; m < 4; ++m) { bf16_t* rowp = O + (size_t)(row0 + ai * HALF + m * 16) * ldc + col0;
#pragma unroll
                for (int bj = 0; bj < 2; ++bj) { f32x4 v0 = acc[ai][bj][m][0], v1 = acc[ai][bj][m][1];
                    if (ACT == 1) {
#pragma unroll
                        for (int j = 0; j < 4; ++j) { float a = v0[j] > 0.f ? v0[j] : 0.f, b = v1[j] > 0.f ? v1[j] : 0.f; v0[j] = a * a; v1[j] = b * b; } }
                    u32x4 w; w.x = cvt_pk_bf16(v0[0], v0[1]); w.y = cvt_pk_bf16(v0[2], v0[3]); w.z = cvt_pk_bf16(v1[0], v1[1]); w.w = cvt_pk_bf16(v1[2], v1[3]);
                    *(u32x4*)(rowp + bj * HALF) = w; } }
    }
};
struct EpiF32 {
    static constexpr bool PERM = true, AFTER_DRAIN = false;
    float* O; int ldc; int pad;
    __device__ __forceinline__ void operator()(const f32x4 (&acc)[2][2][4][2], const Unit& u, int wr, int wc, int fr, int fq) const {
        const int row0 = u.pm * BM + wr * 64 + fr, col0 = u.pn * BM + wc * 32 + 8 * fq;
#pragma unroll
        for (int ai = 0; ai < 2; ++ai)
#pragma unroll
            for (int m = 0; m < 4; ++m) { float* rowp = O + (size_t)(row0 + ai * HALF + m * 16) * ldc + col0;
#pragma unroll
                for (int bj = 0; bj < 2; ++bj) { *(f32x4*)(rowp + bj * HALF) = acc[ai][bj][m][0]; *(f32x4*)(rowp + bj * HALF + 4) = acc[ai][bj][m][1]; } }
    }
};
}

#define LAS __attribute__((address_space(3)))

struct Params {
  const float *x, *c, *w_ada, *b_ada, *pre_mix_w, *post_mix_w, *w_in, *dn_conv_w, *dn_a_log, *dn_dt_bias,
      *dn_norm_w, *sc_conv_w, *w_out, *pre_ffn_w, *post_ffn_w, *w_ff1, *w_ff2;
  float* out;
  unsigned char* ws;
};

__device__ __forceinline__ bf16_t f2bf(float x) {
  unsigned u = __float_as_uint(x);
  u += 0x7fffu + ((u >> 16) & 1u);
  return (bf16_t)(u >> 16);
}
__device__ __forceinline__ float bf2f(bf16_t b) { return __uint_as_float(((unsigned)b) << 16); }
typedef __bf16 bf16x2_t __attribute__((ext_vector_type(2)));
typedef float f32x2 __attribute__((ext_vector_type(2)));
__device__ __forceinline__ unsigned pack2(float lo, float hi) { f32x2 v = {lo, hi}; bf16x2_t r = __builtin_convertvector(v, bf16x2_t); return __builtin_bit_cast(unsigned, r); }
__device__ __forceinline__ float bflo(unsigned u) { return __uint_as_float(u << 16); }
__device__ __forceinline__ float bfhi(unsigned u) { return __uint_as_float(u & 0xffff0000u); }
__device__ __forceinline__ float siluf(float x) { return x / (1.f + __expf(-x)); }
__device__ __forceinline__ float sigmoidf_(float x) { return 1.f / (1.f + __expf(-x)); }
__device__ __forceinline__ float softplusf_(float x) { return x > 20.f ? x : log1pf(expf(x)); }

__device__ __forceinline__ int opaque_tid() { int t = threadIdx.x; asm volatile("" : "+v"(t)); return t; }

__device__ __forceinline__ float wave_sum(float v) {
#pragma unroll
  for (int o = 32; o >= 1; o >>= 1) v += __shfl_xor(v, o);
  return v;
}

__device__ __forceinline__ f32x4 load_mod4(const Params& P, int b, int col) {
  const float* mp = (const float*)(P.ws + WS_MODP);
  f32x4 v = *(const f32x4*)(P.b_ada + col);
#pragma unroll
  for (int s = 0; s < MOD_KS; ++s) v += *(const f32x4*)(mp + ((size_t)s * NB + b) * 6144 + col);
  return v;
}

__device__ __forceinline__ void phase_mod(const Params& P, int item, float* lds) {
  const int ks = item / 48, cg = item % 48, t = opaque_tid(), kq = t >> 7, cl = t & 127;
  float* sc = lds;
  float* red = lds + 2048;
  __syncthreads();
  for (int i = t; i < 8 * 256; i += 512) { int b = i >> 8, k = i & 255; sc[i] = siluf(P.c[b * D + ks * 256 + k]); }
  __syncthreads();
  float acc[8];
#pragma unroll
  for (int b = 0; b < 8; ++b) acc[b] = 0.f;
  const float* wp = P.w_ada + (size_t)(ks * 256 + kq * 64) * 6144 + cg * 128 + cl;
  for (int k = 0; k < 64; ++k) {
    float w = wp[(size_t)k * 6144];
#pragma unroll
    for (int b = 0; b < 8; ++b) acc[b] += sc[b * 256 + kq * 64 + k] * w;
  }
#pragma unroll
  for (int b = 0; b < 8; ++b) red[(kq * 8 + b) * 128 + cl] = acc[b];
  __syncthreads();
  float* mp = (float*)(P.ws + WS_MODP);
  for (int i = t; i < 8 * 128; i += 512) {
    int b = i >> 7, c2 = i & 127;
    float s = red[(0 * 8 + b) * 128 + c2] + red[(1 * 8 + b) * 128 + c2] + red[(2 * 8 + b) * 128 + c2] + red[(3 * 8 + b) * 128 + c2];
    mp[((size_t)ks * NB + b) * 6144 + cg * 128 + c2] = s;
  }
}


__device__ __forceinline__ void transpose_item(const float* W, int ldw, int K, bf16_t* WT, LAS float* scr, int k0, int n0d, int n0s, int lane) {
#pragma unroll 8
  for (int i = 0; i < 32; ++i) { const int kk = 2 * i + (lane >> 5); scr[kk * 33 + (lane & 31)] = W[(size_t)(k0 + kk) * ldw + n0s + (lane & 31)]; }
  asm volatile("s_waitcnt lgkmcnt(0)" ::: "memory");
  const int c = lane & 7;
#pragma unroll
  for (int j = 0; j < 4; ++j) { const int n = (lane >> 3) + 8 * j; const LAS float* sp = scr + (8 * c) * 33 + n;
    u32x4 o; o.x = pack2(sp[0 * 33], sp[1 * 33]); o.y = pack2(sp[2 * 33], sp[3 * 33]); o.z = pack2(sp[4 * 33], sp[5 * 33]); o.w = pack2(sp[6 * 33], sp[7 * 33]);
    *(u32x4*)(WT + (size_t)(n0d + n) * K + k0 + 8 * c) = o; }
  asm volatile("s_waitcnt lgkmcnt(0)" ::: "memory");
}
constexpr int CV_IN = 16 * 112, CV_OUT = 16 * 32, CV_FF1 = 16 * 128, CV_FF2 = 64 * 32, CV_ITEMS = CV_IN + CV_OUT + CV_FF1 + CV_FF2;
__device__ __forceinline__ void phase_convert(const Params& P, int gw, int ngw, LAS float* scr, int lane) {
  for (int it = gw; it < CV_ITEMS; it += ngw) {
    int r = it;
    if (r < CV_IN) { const int kb = r / 112, nb = r % 112, n0 = 32 * nb; transpose_item(P.w_in, DIN, D, (bf16_t*)(P.ws + WS_WT_IN), scr, 64 * kb, n0, n0 + (n0 >= 2048 ? 8 : 0), lane); continue; } r -= CV_IN;
    if (r < CV_OUT) { const int kb = r / 32, nb = r % 32; transpose_item(P.w_out, D, D, (bf16_t*)(P.ws + WS_WT_OUT), scr, 64 * kb, 32 * nb, 32 * nb, lane); continue; } r -= CV_OUT;
    if (r < CV_FF1) { const int kb = r / 128, nb = r % 128; transpose_item(P.w_ff1, DFF, D, (bf16_t*)(P.ws + WS_WT_FF1), scr, 64 * kb, 32 * nb, 32 * nb, lane); continue; } r -= CV_FF1;
    { const int kb = r / 32, nb = r % 32; transpose_item(P.w_ff2, D, DFF, (bf16_t*)(P.ws + WS_WT_FF2), scr, 64 * kb, 32 * nb, 32 * nb, lane); }
  }
}

__device__ __forceinline__ void phase_prenorm(const Params& P, int bid, int nb, float* lds) {
  const int t = opaque_tid(), hf = t >> 8, u = t & 255, wv = t >> 6, lane = t & 63;
  const int rpb = M / nb, r0 = bid * rpb, b = r0 / SEQ;
  bf16_t* H = (bf16_t*)(P.ws + WS_H);
  float* G = (float*)(P.ws + WS_G);
  float* BETA = (float*)(P.ws + WS_BETA);
  f32x4 sh = load_mod4(P, b, 0 * D + 4 * u), sc = load_mod4(P, b, 1 * D + 4 * u);
  f32x4 wn = *(const f32x4*)(P.pre_mix_w + 4 * u);
  f32x4 mulv = wn * (sc + 1.0f);
  float wab[4][8];
#pragma unroll
  for (int kk = 0; kk < 4; ++kk) {
    f32x4 a = *(const f32x4*)(P.w_in + (size_t)(4 * u + kk) * DIN + 2048);
    f32x4 c = *(const f32x4*)(P.w_in + (size_t)(4 * u + kk) * DIN + 2052);
#pragma unroll
    for (int j = 0; j < 4; ++j) { wab[kk][j] = a[j]; wab[kk][4 + j] = c[j]; }
  }
  float* red_ss = lds;
  float* red_ab = lds + 16;
  __syncthreads();
  for (int it = 0; it < rpb / 2; ++it) {
    const int row = r0 + 2 * it + hf, par = it & 1;
    f32x4 xv = *(const f32x4*)(P.x + (size_t)row * D + 4 * u);
    float ss = xv[0] * xv[0] + xv[1] * xv[1] + xv[2] * xv[2] + xv[3] * xv[3];
    ss = wave_sum(ss);
    if (lane == 0) red_ss[par * 8 + wv] = ss;
    __syncthreads();
    float tot = red_ss[par * 8 + hf * 4 + 0] + red_ss[par * 8 + hf * 4 + 1] + red_ss[par * 8 + hf * 4 + 2] + red_ss[par * 8 + hf * 4 + 3];
    float rstd = rsqrtf(tot * (1.0f / D) + EPS);
    f32x4 hv = xv * rstd * mulv + sh;
    u32x2 pk; pk[0] = pack2(hv[0], hv[1]); pk[1] = pack2(hv[2], hv[3]);
    *(u32x2*)(H + (size_t)row * D + 4 * u) = pk;
    float pa[8];
#pragma unroll
    for (int j = 0; j < 8; ++j) pa[j] = hv[0] * wab[0][j] + hv[1] * wab[1][j] + hv[2] * wab[2][j] + hv[3] * wab[3][j];
#pragma unroll
    for (int j = 0; j < 8; ++j) pa[j] = wave_sum(pa[j]);
    if (lane == 0) {
#pragma unroll
      for (int j = 0; j < 8; ++j) red_ab[(par * 8 + wv) * 8 + j] = pa[j];
    }
    __syncthreads();
    if (u < 8) {
      float v = red_ab[(par * 8 + hf * 4 + 0) * 8 + u] + red_ab[(par * 8 + hf * 4 + 1) * 8 + u] + red_ab[(par * 8 + hf * 4 + 2) * 8 + u] + red_ab[(par * 8 + hf * 4 + 3) * 8 + u];
      if (u < 4) {
        float g = -expf(P.dn_a_log[u]) * softplusf_(v + P.dn_dt_bias[u]);
        G[(size_t)row * 4 + u] = g;
      } else {
        BETA[(size_t)row * 4 + (u - 4)] = sigmoidf_(v);
      }
    }
  }
}

typedef short bf16x8 __attribute__((ext_vector_type(8)));
typedef float f32x16 __attribute__((ext_vector_type(16)));
#define MFMA32(a, b, c) __builtin_amdgcn_mfma_f32_32x32x16_bf16((a), (b), (c), 0, 0, 0)
__device__ __forceinline__ int crow(int reg, int hh) { return (reg & 3) + 8 * (reg >> 2) + 4 * hh; }
__device__ __forceinline__ int swap23(int k) { return (k & ~12) | ((k & 4) << 1) | ((k & 8) >> 1); }
template <int S_> __device__ __forceinline__ bf16x8 pack_step(const f32x16& x) {
  u32x4 p; p[0] = pack2(x[8 * S_ + 0], x[8 * S_ + 1]); p[1] = pack2(x[8 * S_ + 2], x[8 * S_ + 3]); p[2] = pack2(x[8 * S_ + 4], x[8 * S_ + 5]); p[3] = pack2(x[8 * S_ + 6], x[8 * S_ + 7]);
  return __builtin_bit_cast(bf16x8, p);
}
__device__ __forceinline__ f32x16 zero16() { f32x16 z;
#pragma unroll
  for (int i = 0; i < 16; ++i) z[i] = 0.f;
  return z; }

constexpr int PA_QS = 0, PA_KS = 17408, PA_KT = 34816, PA_VT = 53248, PA_AM = 71680, PA_T1 = 89088, PA_T2 = 98304, PA_GC = 107520, PA_BETA = 107776, PA_TL = 108032, PA_KDS = 117248;
constexpr float QSCALE = 0.08838834764831845f;
__device__ __forceinline__ void phase_chunk_prep(const Params& P, int ci, LAS unsigned char* lds) {
  const int bh = ci >> 5, n = ci & 31, b = bh >> 2, h = bh & 3;
  const int t = opaque_tid(), w = __builtin_amdgcn_readfirstlane(t >> 6);
  int lane = t & 63, r = lane & 31, hh = lane >> 5;
#define OPAQUE_LANE() do { asm volatile("" : "+v"(lane)); r = lane & 31; hh = lane >> 5; } while (0)
  const bf16_t* PROJ = (const bf16_t*)(P.ws + WS_PROJ);
  const size_t row0 = (size_t)b * SEQ + n * 64;
  LAS float* gcs = (LAS float*)(lds + PA_GC);
  LAS float* betas = (LAS float*)(lds + PA_BETA);
  LAS float* Am = (LAS float*)(lds + PA_AM);
  __syncthreads();
  float gc = ((const float*)(P.ws + WS_G))[(row0 + lane) * 4 + h];
  const float betal = ((const float*)(P.ws + WS_BETA))[(row0 + lane) * 4 + h];
#pragma unroll
  for (int o = 1; o < 64; o <<= 1) { const float v = __shfl_up(gc, o); if (lane >= o) gc += v; }
  const float glast = __shfl(gc, 63);
  if (w == 0) { gcs[lane] = gc; betas[lane] = betal; if (lane == 63) ((float*)(P.ws + WS_GL))[ci] = __expf(gc); }
  OPAQUE_LANE();
  {
    const int t0 = 8 * w, colb = h * HD + 2 * lane;
    float cw[4][3][2];
#pragma unroll
    for (int j = 0; j < 4; ++j)
#pragma unroll
      for (int p = 0; p < 3; ++p) { const f32x2 v2 = *(const f32x2*)(P.dn_conv_w + j * 1536 + p * 512 + colb); cw[j][p][0] = v2[0]; cw[j][p][1] = v2[1]; }
    unsigned raw[11][3];
#pragma unroll
    for (int rr = 0; rr < 11; ++rr) {
      const int tk = n * 64 + t0 - 3 + rr;
#pragma unroll
      for (int p = 0; p < 3; ++p) raw[rr][p] = tk >= 0 ? *(const unsigned*)(PROJ + ((size_t)b * SEQ + tk) * DP + p * 512 + colb) : 0u;
    }
    bf16_t* QG = (bf16_t*)(P.ws + WS_QG);
#pragma unroll
    for (int tt = 0; tt < 8; ++tt) {
      float c[3][2];
#pragma unroll
      for (int p = 0; p < 3; ++p) {
        float a0 = 0.f, a1 = 0.f;
#pragma unroll
        for (int j = 0; j < 4; ++j) { a0 += cw[j][p][0] * bflo(raw[tt + j][p]); a1 += cw[j][p][1] * bfhi(raw[tt + j][p]); }
        c[p][0] = siluf(a0); c[p][1] = siluf(a1);
      }
      const float rq = rsqrtf(wave_sum(c[0][0] * c[0][0] + c[0][1] * c[0][1]) + EPS) * QSCALE;
      const float rk = rsqrtf(wave_sum(c[1][0] * c[1][0] + c[1][1] * c[1][1]) + EPS);
      const float q0 = c[0][0] * rq, q1 = c[0][1] * rq, k0 = c[1][0] * rk, k1 = c[1][1] * rk;
      const int tok = t0 + tt;
      const float gct = __shfl(gc, tok);
      const float egc = __expf(gct), ekd = __expf(glast - gct);
      *(LAS unsigned*)(lds + PA_QS + tok * 272 + 4 * lane) = pack2(q0, q1);
      const unsigned kp = pack2(k0, k1), vp = pack2(c[2][0], c[2][1]), dp = pack2(k0 * ekd, k1 * ekd);
      *(LAS unsigned*)(lds + PA_KS + tok * 272 + 4 * lane) = kp;
      *(unsigned*)(QG + ((size_t)ci * 64 + tok) * 128 + swap23(2 * lane)) = pack2(q0 * egc, q1 * egc);
      *(LAS bf16_t*)(lds + PA_KT + (2 * lane) * 144 + tok * 2) = (bf16_t)(kp & 0xffffu);
      *(LAS bf16_t*)(lds + PA_KT + (2 * lane + 1) * 144 + tok * 2) = (bf16_t)(kp >> 16);
      *(LAS bf16_t*)(lds + PA_VT + (2 * lane) * 144 + tok * 2) = (bf16_t)(vp & 0xffffu);
      *(LAS bf16_t*)(lds + PA_VT + (2 * lane + 1) * 144 + tok * 2) = (bf16_t)(vp >> 16);
      *(LAS bf16_t*)(lds + PA_KDS + (2 * lane) * 144 + tok * 2) = (bf16_t)(dp & 0xffffu);
      *(LAS bf16_t*)(lds + PA_KDS + (2 * lane + 1) * 144 + tok * 2) = (bf16_t)(dp >> 16);
    }
  }
  __syncthreads();
  OPAQUE_LANE();
  if (w < 3) {
    const int ti = (w >= 1) ? 1 : 0, tj = (w == 2) ? 1 : 0;
    f32x16 acc = zero16();
#pragma unroll
    for (int ks = 0; ks < 8; ++ks) {
      const bf16x8 a = *(const LAS bf16x8*)(lds + PA_KS + (32 * ti + r) * 272 + (16 * ks + 8 * hh) * 2);
      const bf16x8 bb = *(const LAS bf16x8*)(lds + PA_KS + (32 * tj + r) * 272 + (16 * ks + 8 * hh) * 2);
      acc = MFMA32(a, bb, acc);
    }
    const int j = 32 * tj + r; const float gcj = gcs[j];
#pragma unroll
    for (int reg = 0; reg < 16; ++reg) {
      const int i = 32 * ti + crow(reg, hh);
      const float dec = __expf(fminf(gcs[i] - gcj, 0.f));
      Am[i * 68 + j] = (i > j) ? betas[i] * acc[reg] * dec : 0.f;
    }
  } else if (w < 7) {
    const int idx = w - 3, tj = (idx >= 2) ? 1 : 0, ti = (idx == 1 || idx == 2) ? 1 : 0;
    f32x16 acc = zero16();
    if (!(tj == 1 && ti == 0)) {
#pragma unroll
      for (int ks = 0; ks < 8; ++ks) {
        const bf16x8 a = *(const LAS bf16x8*)(lds + PA_KS + (32 * tj + r) * 272 + (16 * ks + 8 * hh) * 2);
        const bf16x8 bb = *(const LAS bf16x8*)(lds + PA_QS + (32 * ti + r) * 272 + (16 * ks + 8 * hh) * 2);
        acc = MFMA32(a, bb, acc);
      }
    }
    const int i = 32 * ti + r; const float gci = gcs[i];
    f32x16 x;
#pragma unroll
    for (int reg = 0; reg < 16; ++reg) {
      const int j = 32 * tj + crow(reg, hh);
      const float dec = __expf(fminf(gci - gcs[j], 0.f));
      x[reg] = (i >= j) ? acc[reg] * dec : 0.f;
    }
    bf16_t* ATT = (bf16_t*)(P.ws + WS_ATT) + ((size_t)ci * 64 + i) * 64 + 32 * tj + 8 * hh;
    *(bf16x8*)(ATT) = pack_step<0>(x);
    *(bf16x8*)(ATT + 16) = pack_step<1>(x);
  } else {
    bf16_t* KD = (bf16_t*)(P.ws + WS_KD) + (size_t)ci * 128 * 64;
#pragma unroll 4
    for (int it = 0; it < 16; ++it) {
      const int idx = it * 64 + lane, dk = idx >> 3, pp = idx & 7;
      const u32x2 lo = *(const LAS u32x2*)(lds + PA_KDS + dk * 144 + swap23(8 * pp) * 2);
      const u32x2 hi = *(const LAS u32x2*)(lds + PA_KDS + dk * 144 + swap23(8 * pp + 4) * 2);
      u32x4 o; o[0] = lo[0]; o[1] = lo[1]; o[2] = hi[0]; o[3] = hi[1];
      *(u32x4*)(KD + dk * 64 + 8 * pp) = o;
    }
  }
  __syncthreads();
  OPAQUE_LANE();
  if (w == 0) {
    const int d = hh, c = r;
    LAS float* TL = (LAS float*)(lds + PA_TL);
    const LAS float* Ad = Am + (32 * d) * 68 + 32 * d;
    float T[32];
#pragma unroll
    for (int i = 0; i < 32; ++i) {
      float acc = (c == i) ? 1.f : 0.f;
#pragma unroll
      for (int j = 0; j < i; ++j) acc -= Ad[i * 68 + j] * T[j];
      T[i] = acc;
    }
#pragma unroll
    for (int i = 0; i < 32; ++i) TL[(32 * d + i) * 36 + c] = T[i];
    f32x16 X = zero16(), Y = zero16();
#pragma unroll
    for (int ks = 0; ks < 16; ++ks) X = __builtin_amdgcn_mfma_f32_32x32x2f32(Am[(32 + r) * 68 + 2 * ks + hh], TL[(2 * ks + hh) * 36 + r], X, 0, 0, 0);
#pragma unroll
    for (int s2 = 0; s2 < 16; ++s2) Y = __builtin_amdgcn_mfma_f32_32x32x2f32(TL[(32 + r) * 36 + crow(s2, hh)], X[s2], Y, 0, 0, 0);
    {
      const float bc = betas[32 * d + c], bg = -bc * __expf(gcs[32 * d + c]);
#pragma unroll
      for (int i = 0; i < 32; ++i) {
        *(LAS bf16_t*)(lds + PA_T1 + (32 * d + i) * 144 + 2 * (32 * d + c)) = (bf16_t)(pack2(T[i] * bc, 0.f) & 0xffffu);
        *(LAS bf16_t*)(lds + PA_T2 + (32 * d + i) * 144 + 2 * (32 * d + c)) = (bf16_t)(pack2(T[i] * bg, 0.f) & 0xffffu);
      }
    }
    {
      const float bc = betas[r], bg = -bc * __expf(gcs[r]);
#pragma unroll
      for (int reg = 0; reg < 16; ++reg) {
        const int i = crow(reg, hh);
        *(LAS bf16_t*)(lds + PA_T1 + (32 + i) * 144 + 2 * r) = (bf16_t)(pack2(-Y[reg] * bc, 0.f) & 0xffffu);
        *(LAS bf16_t*)(lds + PA_T2 + (32 + i) * 144 + 2 * r) = (bf16_t)(pack2(-Y[reg] * bg, 0.f) & 0xffffu);
        *(LAS bf16_t*)(lds + PA_T1 + i * 144 + 2 * (32 + r)) = (bf16_t)0;
        *(LAS bf16_t*)(lds + PA_T2 + i * 144 + 2 * (32 + r)) = (bf16_t)0;
      }
    }
  }
  __syncthreads();
  OPAQUE_LANE();
  {
    const int mt = w >> 2, nt = w & 3;
    f32x16 acc = zero16();
#pragma unroll
    for (int ks = 0; ks < 4; ++ks) {
      const bf16x8 a = *(const LAS bf16x8*)(lds + PA_T1 + (32 * mt + r) * 144 + (16 * ks + 8 * hh) * 2);
      const bf16x8 bb = *(const LAS bf16x8*)(lds + PA_VT + (32 * nt + r) * 144 + (16 * ks + 8 * hh) * 2);
      acc = MFMA32(a, bb, acc);
    }
    float* U = (float*)(P.ws + WS_U) + ((((size_t)ci * 4 + nt) * 2 + mt) * 4) * 256 + lane * 4;
#pragma unroll
    for (int q = 0; q < 4; ++q) { f32x4 v4 = {acc[4 * q], acc[4 * q + 1], acc[4 * q + 2], acc[4 * q + 3]}; *(f32x4*)(U + q * 256) = v4; }
    const int dt = w >> 1, it = w & 1;
    f32x16 acc2 = zero16();
#pragma unroll
    for (int ks = 0; ks < 4; ++ks) {
      const bf16x8 a = *(const LAS bf16x8*)(lds + PA_KT + (32 * dt + r) * 144 + (16 * ks + 8 * hh) * 2);
      const bf16x8 bb = *(const LAS bf16x8*)(lds + PA_T2 + (32 * it + r) * 144 + (16 * ks + 8 * hh) * 2);
      acc2 = MFMA32(a, bb, acc2);
    }
    bf16_t* WN = (bf16_t*)(P.ws + WS_WN) + ((size_t)ci * 64 + 32 * it + r) * 128 + 32 * dt + 8 * hh;
    *(bf16x8*)(WN) = pack_step<0>(acc2);
    *(bf16x8*)(WN + 16) = pack_step<1>(acc2);
  }
}

constexpr int SC_WN = 0, SC_QG = 17408, SC_KD = 34816, SC_ATT = 53248, SC_U = 62464, SC_SLOT = 70656;
__device__ __forceinline__ void scan_piece(int p, int ci, int dvs, const unsigned char* ws, const unsigned char*& src, int& dst) {
  if (p < 1024) { src = ws + WS_WN + (size_t)ci * 16384 + p * 16; dst = SC_WN + (p >> 4) * 272 + (p & 15) * 16; }
  else if (p < 2048) { const int q = p - 1024; src = ws + WS_QG + (size_t)ci * 16384 + q * 16; dst = SC_QG + (q >> 4) * 272 + (q & 15) * 16; }
  else if (p < 3072) { const int q = p - 2048; src = ws + WS_KD + (size_t)ci * 16384 + q * 16; dst = SC_KD + (q >> 3) * 144 + (q & 7) * 16; }
  else if (p < 3584) { const int q = p - 3072; src = ws + WS_ATT + (size_t)ci * 8192 + q * 16; dst = SC_ATT + (q >> 3) * 144 + (q & 7) * 16; }
  else { const int q = p - 3584; src = ws + WS_U + ((size_t)ci * 4 + dvs) * 8192 + q * 16; dst = SC_U + q * 16; }
}
#define SCAN_BAR() do { asm volatile("s_waitcnt lgkmcnt(0)" ::: "memory"); __builtin_amdgcn_s_barrier(); asm volatile("" ::: "memory"); } while (0)
__device__ __forceinline__ void phase_scan(const Params& P, int item, LAS unsigned char* lds) {
  const int bh = item >> 2, dvs = item & 3, b = bh >> 2, h = bh & 3;
  const int t = opaque_tid(), w = __builtin_amdgcn_readfirstlane(t >> 6), lane = t & 63, r = lane & 31, hh = lane >> 5;
  const int ci0 = bh * 32, ltid = t - 64;
  const unsigned char* ws = P.ws;
  __syncthreads();
  if (w > 0) {
    u32x4 R[10];
#pragma unroll
    for (int k = 0; k < 10; ++k) { const int p = ltid + 448 * k; if (p < 4096) { const unsigned char* src; int dst; scan_piece(p, ci0, dvs, ws, src, dst); R[k] = *(const u32x4*)src; } }
#pragma unroll
    for (int k = 0; k < 10; ++k) { const int p = ltid + 448 * k; if (p < 4096) { const unsigned char* src; int dst; scan_piece(p, ci0, dvs, ws, src, dst); *(LAS u32x4*)(lds + dst) = R[k]; } }
#pragma unroll
    for (int k = 0; k < 10; ++k) { const int p = ltid + 448 * k; if (p < 4096) { const unsigned char* src; int dst; scan_piece(p, ci0 + 1, dvs, ws, src, dst); R[k] = *(const u32x4*)src; } }
    SCAN_BAR();
    for (int n = 0; n < 32; ++n) {
      if (n + 1 < 32) {
        const int so = ((n + 1) & 1) * SC_SLOT;
#pragma unroll
        for (int k = 0; k < 10; ++k) { const int p = ltid + 448 * k; if (p < 4096) { const unsigned char* src; int dst; scan_piece(p, ci0, dvs, ws, src, dst); *(LAS u32x4*)(lds + so + dst) = R[k]; } }
      }
      if (n + 2 < 32) {
#pragma unroll
        for (int k = 0; k < 10; ++k) { const int p = ltid + 448 * k; if (p < 4096) { const unsigned char* src; int dst; scan_piece(p, ci0 + n + 2, dvs, ws, src, dst); R[k] = *(const u32x4*)src; } }
      }
      SCAN_BAR();
    }
  } else {
    f32x16 S[4];
#pragma unroll
    for (int kt = 0; kt < 4; ++kt) S[kt] = zero16();
    SCAN_BAR();
    for (int n = 0; n < 32; ++n) {
      const LAS unsigned char* sl = lds + (n & 1) * SC_SLOT;
      const float egl = ((const float*)(ws + WS_GL))[ci0 + n];
      bf16x8 Sb[8];
      Sb[0] = pack_step<0>(S[0]); Sb[1] = pack_step<1>(S[0]); Sb[2] = pack_step<0>(S[1]); Sb[3] = pack_step<1>(S[1]);
      Sb[4] = pack_step<0>(S[2]); Sb[5] = pack_step<1>(S[2]); Sb[6] = pack_step<0>(S[3]); Sb[7] = pack_step<1>(S[3]);
      f32x16 av[2], ao[2];
#pragma unroll
      for (int mt = 0; mt < 2; ++mt) {
#pragma unroll
        for (int q = 0; q < 4; ++q) { const f32x4 uq = *(const LAS f32x4*)(sl + SC_U + ((mt * 4 + q) * 64 + lane) * 16); av[mt][4 * q] = uq[0]; av[mt][4 * q + 1] = uq[1]; av[mt][4 * q + 2] = uq[2]; av[mt][4 * q + 3] = uq[3]; }
        ao[mt] = zero16();
      }
#pragma unroll
      for (int mt = 0; mt < 2; ++mt)
#pragma unroll
        for (int ks = 0; ks < 8; ++ks) {
          const bf16x8 a = *(const LAS bf16x8*)(sl + SC_WN + (32 * mt + r) * 272 + (16 * ks + 8 * hh) * 2);
          av[mt] = MFMA32(a, Sb[ks], av[mt]);
        }
#pragma unroll
      for (int mt = 0; mt < 2; ++mt)
#pragma unroll
        for (int ks = 0; ks < 8; ++ks) {
          const bf16x8 a = *(const LAS bf16x8*)(sl + SC_QG + (32 * mt + r) * 272 + (16 * ks + 8 * hh) * 2);
          ao[mt] = MFMA32(a, Sb[ks], ao[mt]);
        }
      bf16x8 Vb[4];
      Vb[0] = pack_step<0>(av[0]); Vb[1] = pack_step<1>(av[0]); Vb[2] = pack_step<0>(av[1]); Vb[3] = pack_step<1>(av[1]);
#pragma unroll
      for (int mt = 0; mt < 2; ++mt)
#pragma unroll
        for (int ks = 0; ks < 4; ++ks) {
          const bf16x8 a = *(const LAS bf16x8*)(sl + SC_ATT + (32 * mt + r) * 144 + (16 * ks + 8 * hh) * 2);
          ao[mt] = MFMA32(a, Vb[ks], ao[mt]);
        }
#pragma unroll
      for (int kt = 0; kt < 4; ++kt) {
        S[kt] = S[kt] * egl;
#pragma unroll
        for (int ks = 0; ks < 4; ++ks) {
          const bf16x8 a = *(const LAS bf16x8*)(sl + SC_KD + (32 * kt + r) * 144 + (16 * ks + 8 * hh) * 2);
          S[kt] = MFMA32(a, Vb[ks], S[kt]);
        }
      }
      bf16_t* O = (bf16_t*)(P.ws + WS_O) + ((size_t)b * SEQ + n * 64) * 512 + h * HD + 32 * dvs + r;
#pragma unroll
      for (int mt = 0; mt < 2; ++mt)
#pragma unroll
        for (int reg = 0; reg < 16; ++reg) O[(size_t)(32 * mt + crow(reg, hh)) * 512] = (bf16_t)(pack2(ao[mt][reg], 0.f) & 0xffffu);
      SCAN_BAR();
    }
  }
  __syncthreads();
}

__device__ __forceinline__ void phase_gate_mix(const Params& P, int bid, int nb) {
  const int t = opaque_tid(), hf = t >> 8, u = t & 255;
  const bf16_t* PROJ = (const bf16_t*)(P.ws + WS_PROJ);
  const bf16_t* O = (const bf16_t*)(P.ws + WS_O);
  bf16_t* MIX = (bf16_t*)(P.ws + WS_MIX);
  for (int rp = bid; rp < M / 2; rp += nb) {
    const int row = 2 * rp + hf, tk = row % SEQ;
    if (u < 128) {
      const int col = 4 * u;
      u32x2 ov = *(const u32x2*)(O + (size_t)row * 512 + col);
      float o0 = bflo(ov[0]), o1 = bfhi(ov[0]), o2 = bflo(ov[1]), o3 = bfhi(ov[1]);
      float ss = o0 * o0 + o1 * o1 + o2 * o2 + o3 * o3;
#pragma unroll
      for (int o = 16; o >= 1; o >>= 1) ss += __shfl_xor(ss, o);
      const float rstd = rsqrtf(ss * (1.0f / HD) + EPS);
      u32x2 zv = *(const u32x2*)(PROJ + (size_t)row * DP + OFF_Z + col);
      f32x4 nw = *(const f32x4*)(P.dn_norm_w + (col & 127));
      float r0 = o0 * rstd * nw[0] * siluf(bflo(zv[0])), r1 = o1 * rstd * nw[1] * siluf(bfhi(zv[0]));
      float r2 = o2 * rstd * nw[2] * siluf(bflo(zv[1])), r3 = o3 * rstd * nw[3] * siluf(bfhi(zv[1]));
      u32x2 pk; pk[0] = pack2(r0, r1); pk[1] = pack2(r2, r3);
      *(u32x2*)(MIX + (size_t)row * D + col) = pk;
    } else {
      const int col = 4 * (u - 128);
      float acc[4] = {0.f, 0.f, 0.f, 0.f};
#pragma unroll
      for (int j = 0; j < 3; ++j) {
        const int dt = 2 - j;
        if (tk - dt >= 0) {
          u32x2 cv = *(const u32x2*)(PROJ + (size_t)(row - dt) * DP + OFF_SC + col);
          u32x2 hv = *(const u32x2*)(PROJ + (size_t)(row - dt) * DP + OFF_SH + col);
          f32x4 w = *(const f32x4*)(P.sc_conv_w + j * 512 + col);
          acc[0] += w[0] * bflo(cv[0]) * bflo(hv[0]); acc[1] += w[1] * bfhi(cv[0]) * bfhi(hv[0]);
          acc[2] += w[2] * bflo(cv[1]) * bflo(hv[1]); acc[3] += w[3] * bfhi(cv[1]) * bfhi(hv[1]);
        }
      }
      u32x2 bv = *(const u32x2*)(PROJ + (size_t)row * DP + OFF_SB + col);
      u32x2 pk; pk[0] = pack2(acc[0] * bflo(bv[0]), acc[1] * bfhi(bv[0])); pk[1] = pack2(acc[2] * bflo(bv[1]), acc[3] * bfhi(bv[1]));
      *(u32x2*)(MIX + (size_t)row * D + 512 + col) = pk;
    }
  }
}

__device__ __forceinline__ void phase_post1(const Params& P, int bid, int nb, float* lds) {
  const int t = opaque_tid(), hf = t >> 8, u = t & 255, wv = t >> 6, lane = t & 63;
  const int rpb = M / nb, r0 = bid * rpb, b = r0 / SEQ;
  const float* Y = (const float*)(P.ws + WS_Y);
  bf16_t* H2 = (bf16_t*)(P.ws + WS_H2);
  f32x4 gm = load_mod4(P, b, 2 * D + 4 * u), shf = load_mod4(P, b, 3 * D + 4 * u), scf = load_mod4(P, b, 4 * D + 4 * u);
  f32x4 wpost = *(const f32x4*)(P.post_mix_w + 4 * u), wpre = *(const f32x4*)(P.pre_ffn_w + 4 * u);
  f32x4 m1 = gm * wpost, m2 = wpre * (scf + 1.0f);
  float* red = lds;
  __syncthreads();
  for (int it = 0; it < rpb / 2; ++it) {
    const int row = r0 + 2 * it + hf, par = it & 1;
    f32x4 yv = *(const f32x4*)(Y + (size_t)row * D + 4 * u);
    f32x4 xv = *(const f32x4*)(P.x + (size_t)row * D + 4 * u);
    float ss = wave_sum(yv[0] * yv[0] + yv[1] * yv[1] + yv[2] * yv[2] + yv[3] * yv[3]);
    if (lane == 0) red[(par * 2 + 0) * 8 + wv] = ss;
    __syncthreads();
    const float* rr = red + (par * 2 + 0) * 8 + hf * 4;
    float rstd = rsqrtf((rr[0] + rr[1] + rr[2] + rr[3]) * (1.0f / D) + EPS);
    f32x4 x1 = xv + yv * rstd * m1;
    *(f32x4*)(P.out + (size_t)row * D + 4 * u) = x1;
    float ss2 = wave_sum(x1[0] * x1[0] + x1[1] * x1[1] + x1[2] * x1[2] + x1[3] * x1[3]);
    if (lane == 0) red[(par * 2 + 1) * 8 + wv] = ss2;
    __syncthreads();
    const float* rr2 = red + (par * 2 + 1) * 8 + hf * 4;
    float rstd2 = rsqrtf((rr2[0] + rr2[1] + rr2[2] + rr2[3]) * (1.0f / D) + EPS);
    f32x4 hv = x1 * rstd2 * m2 + shf;
    u32x2 pk; pk[0] = pack2(hv[0], hv[1]); pk[1] = pack2(hv[2], hv[3]);
    *(u32x2*)(H2 + (size_t)row * D + 4 * u) = pk;
  }
}

__device__ __forceinline__ void phase_final(const Params& P, int bid, int nb, float* lds) {
  const int t = opaque_tid(), hf = t >> 8, u = t & 255, wv = t >> 6, lane = t & 63;
  const int rpb = M / nb, r0 = bid * rpb, b = r0 / SEQ;
  const float* Y2 = (const float*)(P.ws + WS_Y2);
  f32x4 gf = load_mod4(P, b, 5 * D + 4 * u);
  f32x4 wpost = *(const f32x4*)(P.post_ffn_w + 4 * u);
  f32x4 m1 = gf * wpost;
  float* red = lds;
  __syncthreads();
  for (int it = 0; it < rpb / 2; ++it) {
    const int row = r0 + 2 * it + hf, par = it & 1;
    f32x4 yv = *(const f32x4*)(Y2 + (size_t)row * D + 4 * u);
    f32x4 xv = *(const f32x4*)(P.out + (size_t)row * D + 4 * u);
    float ss = wave_sum(yv[0] * yv[0] + yv[1] * yv[1] + yv[2] * yv[2] + yv[3] * yv[3]);
    if (lane == 0) red[par * 8 + wv] = ss;
    __syncthreads();
    const float* rr = red + par * 8 + hf * 4;
    float rstd = rsqrtf((rr[0] + rr[1] + rr[2] + rr[3]) * (1.0f / D) + EPS);
    *(f32x4*)(P.out + (size_t)row * D + 4 * u) = xv + yv * rstd * m1;
  }
}

__global__ void __launch_bounds__(512, 2) k_mega(Params P) {
  __shared__ __attribute__((aligned(16))) unsigned char lds[2 * SC_SLOT];
  cg::grid_group grid = cg::this_grid();
  const int bid = blockIdx.x, nb = gridDim.x, wv = threadIdx.x >> 6, lane = threadIdx.x & 63;
  unsigned char* ws = P.ws;
  for (int it = bid; it < 192; it += nb) phase_mod(P, it, (float*)lds);
  __syncthreads();
  phase_convert(P, bid * 8 + wv, nb * 8, (LAS float*)lds + wv * 2112, lane);
  grid.sync();
  phase_prenorm(P, bid, nb, (float*)lds);
  grid.sync();
  { pg8::Gemm g{(const bf16_t*)(ws + WS_H), (const bf16_t*)(ws + WS_WT_IN), M, DP, D}; pg8::StaticOrder S; S.init(M, DP, nb, bid);
    pg8::EpiBf16<0> E{(bf16_t*)(ws + WS_PROJ), DP, 0};
    pg8::gemm_phase<pg8::EpiBf16<0>, pg8::StaticOrder, true, true>((PG8_LAS unsigned char*)lds, g, S, E); }
  grid.sync();
  for (int ci = bid; ci < 1024; ci += nb) phase_chunk_prep(P, ci, (LAS unsigned char*)lds);
  grid.sync();
  for (int it = bid; it < 128; it += nb) phase_scan(P, it, (LAS unsigned char*)lds);
  grid.sync();
  phase_gate_mix(P, bid, nb);
  grid.sync();
  { pg8::Gemm g{(const bf16_t*)(ws + WS_MIX), (const bf16_t*)(ws + WS_WT_OUT), M, D, D}; pg8::StaticOrder S; S.init(M, D, nb, bid);
    pg8::EpiF32 E{(float*)(ws + WS_Y), D, 0};
    pg8::gemm_phase<pg8::EpiF32, pg8::StaticOrder, true, true>((PG8_LAS unsigned char*)lds, g, S, E); }
  grid.sync();
  phase_post1(P, bid, nb, (float*)lds);
  grid.sync();
  { pg8::Gemm g{(const bf16_t*)(ws + WS_H2), (const bf16_t*)(ws + WS_WT_FF1), M, DFF, D}; pg8::StaticOrder S; S.init(M, DFF, nb, bid);
    pg8::EpiBf16<1> E{(bf16_t*)(ws + WS_HID), DFF, 0};
    pg8::gemm_phase<pg8::EpiBf16<1>, pg8::StaticOrder, true, true>((PG8_LAS unsigned char*)lds, g, S, E); }
  grid.sync();
  { pg8::Gemm g{(const bf16_t*)(ws + WS_HID), (const bf16_t*)(ws + WS_WT_FF2), M, D, DFF}; pg8::StaticOrder S; S.init(M, D, nb, bid);
    pg8::EpiF32 E{(float*)(ws + WS_Y2), D, 0};
    pg8::gemm_phase<pg8::EpiF32, pg8::StaticOrder, true, true>((PG8_LAS unsigned char*)lds, g, S, E); }
  grid.sync();
  phase_final(P, bid, nb, (float*)lds);
}

extern "C" void kernel_launch(void* const* d_in, const int* in_sizes, int n_in, void* d_out, int out_size, void* d_ws, size_t ws_size,
                              hipStream_t stream) {
  static int grid_blocks = 0;
  if (!grid_blocks) {
    int dev = 0, cus = 0, per_cu = 0;
    hipGetDevice(&dev);
    hipDeviceGetAttribute(&cus, hipDeviceAttributeMultiprocessorCount, dev);
    hipOccupancyMaxActiveBlocksPerMultiprocessor(&per_cu, (const void*)k_mega, 512, 0);
    if (per_cu < 1) per_cu = 1;
    grid_blocks = cus * per_cu;
    if (grid_blocks > 256) grid_blocks = 256;
    if (grid_blocks < 256) { int g = 1; while (g * 2 <= grid_blocks) g *= 2; grid_blocks = g; }
  }
  Params P{};
  P.x = (const float*)d_in[0]; P.c = (const float*)d_in[1]; P.w_ada = (const float*)d_in[2]; P.b_ada = (const float*)d_in[3];
  P.pre_mix_w = (const float*)d_in[4]; P.post_mix_w = (const float*)d_in[5]; P.w_in = (const float*)d_in[6];
  P.dn_conv_w = (const float*)d_in[7]; P.dn_a_log = (const float*)d_in[8]; P.dn_dt_bias = (const float*)d_in[9];
  P.dn_norm_w = (const float*)d_in[10]; P.sc_conv_w = (const float*)d_in[11]; P.w_out = (const float*)d_in[12];
  P.pre_ffn_w = (const float*)d_in[13]; P.post_ffn_w = (const float*)d_in[14]; P.w_ff1 = (const float*)d_in[15];
  P.w_ff2 = (const float*)d_in[16];
  P.out = (float*)d_out; P.ws = (unsigned char*)d_ws;
  void* args[] = {&P};
  hipError_t e = hipLaunchCooperativeKernel((const void*)k_mega, dim3(grid_blocks), dim3(512), args, 0, stream);
  if (e != hipSuccess) fprintf(stderr, "cooperative launch failed: %s (grid %d)\n", hipGetErrorString(e), grid_blocks);
}

#ifdef PHASE_TEST
__global__ void __launch_bounds__(512, 2) k_t_prep(Params P) { __shared__ __attribute__((aligned(16))) unsigned char lds[2 * SC_SLOT]; for (int ci = blockIdx.x; ci < 1024; ci += gridDim.x) phase_chunk_prep(P, ci, (LAS unsigned char*)lds); }
__global__ void __launch_bounds__(512, 2) k_t_scan(Params P) { __shared__ __attribute__((aligned(16))) unsigned char lds[2 * SC_SLOT]; for (int it = blockIdx.x; it < 128; it += gridDim.x) phase_scan(P, it, (LAS unsigned char*)lds); }
__global__ void __launch_bounds__(512, 2) k_t_pre(Params P) { __shared__ __attribute__((aligned(16))) unsigned char lds[2 * SC_SLOT]; phase_prenorm(P, blockIdx.x, gridDim.x, (float*)lds); }
#endif
```

```cpp
#include <hip/hip_runtime.h>
#include <hip/hip_bf16.h>
#include <hip/hip_cooperative_groups.h>
#include <stdint.h>
#include <cstdio>
namespace cg = cooperative_groups;

typedef unsigned short bf16_t;
typedef float f32x4 __attribute__((ext_vector_type(4)));
typedef unsigned u32x2 __attribute__((ext_vector_type(2)));
typedef unsigned u32x4 __attribute__((ext_vector_type(4)));

constexpr int D = 1024, NB = 8, SEQ = 2048, M = NB * SEQ, DIN = 3592, DP = 3584, DFF = 4096;
constexpr int NH = 4, HD = 128;
constexpr float EPS = 1e-6f;
constexpr int OFF_Q = 0, OFF_K = 512, OFF_V = 1024, OFF_Z = 1536, OFF_SB = 2048, OFF_SC = 2560, OFF_SH = 3072;
constexpr int MOD_KS = 4;

constexpr size_t MiB = 1ull << 20;
constexpr size_t WS_WT_IN = 0, WS_WT_OUT = 7 * MiB, WS_WT_FF1 = 9 * MiB, WS_WT_FF2 = 17 * MiB;
constexpr size_t WS_MODP = 25 * MiB;
constexpr size_t WS_G = 25 * MiB + 768 * 1024;
constexpr size_t WS_BETA = 26 * MiB;
constexpr size_t WS_PROJ = 27 * MiB;
constexpr size_t WS_H = 139 * MiB;
constexpr size_t WS_GL = 26 * MiB + 256 * 1024;
constexpr size_t WS_BAR = 26 * MiB + 512 * 1024;
constexpr size_t WS_QG = 139 * MiB;
constexpr size_t WS_KD = 155 * MiB;
constexpr size_t WS_WN = 171 * MiB;
constexpr size_t WS_ATT = 187 * MiB;
constexpr size_t WS_U = 195 * MiB;
constexpr size_t WS_O = 227 * MiB;
constexpr size_t WS_MIX = 139 * MiB;
constexpr size_t WS_Y = 27 * MiB;
constexpr size_t WS_HID = 27 * MiB;
constexpr size_t WS_H2 = 160 * MiB;
constexpr size_t WS_Y2 = 192 * MiB;

namespace pg8 {
#define PG8_LAS __attribute__((address_space(3)))
typedef unsigned short bf16_t;
typedef short bf16x8 __attribute__((ext_vector_type(8)));
typedef float f32x4 __attribute__((ext_vector_type(4)));
typedef unsigned u32x4 __attribute__((ext_vector_type(4)));
constexpr int BM = 256, BK = 64, HALF = 128, HTB = HALF * BK * 2  , STAGE_BYTES = 8 * HTB, NXCD = 8, WGM = 8;

__host__ __device__ __forceinline__ int lds_byte(int r, int c) { const int st = (r >> 4) * 2 + (c >> 5), rr = r & 15, cc = c & 31, ob = rr * 64 + cc * 2; return st * 1024 + (ob ^ (((ob >> 9) & 1) << 5)); }
__host__ __device__ __forceinline__ void stage_rc(int b, int& R, int& C) { const int st = b / 1024, sb = b % 1024, swz = sb ^ (((sb >> 9) & 1) << 5); R = (st >> 1) * 16 + swz / 64; C = (st & 1) * 32 + (swz % 64) / 2; }
__host__ __device__ __forceinline__ int perm32(int rho) { const int n = rho >> 4, i = rho & 15; return 8 * (i >> 2) + 4 * n + (i & 3); }

struct Unit { int pm, pn; };
struct Gemm { const bf16_t* A; const bf16_t* Bt; int M, N, K; };

struct StaticOrder {
    int nM, nN, nwg, G, c;
    __host__ __device__ void init(int M, int N, int G_, int c_) { nM = M / BM; nN = N / BM; nwg = nM * nN; G = G_; c = c_; }
    __host__ __device__ bool next(int i, Unit& u) const {
        const long L = (long)i * G + c; if (L >= nwg) return false;
        int wgid = (int)L; { const int q = nwg / NXCD, r = nwg % NXCD, xcd = wgid % NXCD, off = wgid / NXCD; wgid = (xcd < r ? xcd * (q + 1) : r * (q + 1) + (xcd - r) * q) + off; }
        const int nig = WGM * nN, gid = wgid / nig, fm = gid * WGM, gsz = (nM - fm) < WGM ? (nM - fm) : WGM;
        u.pm = fm + ((wgid % nig) % gsz); u.pn = (wgid % nig) / gsz; return true;
    }
    __device__ __forceinline__ void a_ready(const Unit&) const {}
    __device__ __forceinline__ void done(const Unit&) const {}
};

__device__ __forceinline__ unsigned cvt_pk_bf16(float lo, float hi) { unsigned r; asm volatile("v_cvt_pk_bf16_f32 %0, %1, %2" : "=v"(r) : "v"(lo), "v"(hi)); return r; }
template <class Epi, class Sched, bool ALIGN_EPI = false, bool SP2 = false>
__device__ __forceinline__ void gemm_phase(PG8_LAS unsigned char* lds, const Gemm g, const Sched& S, const Epi& E) {
    int tid_ = threadIdx.x; asm volatile("" : "+v"(tid_));
    const int tid = tid_, wid = __builtin_amdgcn_readfirstlane(tid >> 6), lane = tid & 63, wr = wid >> 2, wc = wid & 3, fr = lane & 15, fq = lane >> 4;
    const int K = g.K, nt = K / BK;
    unsigned voffA[2], voffB[2];
#pragma unroll
    for (int i = 0; i < 2; ++i) { int R, C; stage_rc(tid * 16 + i * 8192, R, C); const int Rb = Epi::PERM ? ((R & ~31) + perm32(R & 31)) : R;
        voffA[i] = (unsigned)(R * K + C) * 2u; voffB[i] = (unsigned)(Rb * K + C) * 2u; }
    const size_t kstep = (size_t)(BK * 2);
    const size_t hstep = (size_t)HALF * K * 2;
    const size_t tstep = 2 * hstep;
    const unsigned ldsw = (unsigned)wid * 1024u;
    const int aoff = lds_byte(wr * 64 + fr, fq * 8), boff = lds_byte(wc * 32 + fr, fq * 8);
#define PG8_SA(b, h) (((b) * 2 + (h)) * HTB)
#define PG8_SB(b, h) ((4 + (b) * 2 + (h)) * HTB)
#define PG8_STAGE(bufoff, gbase, voff) do { _Pragma("unroll") for (int _i = 0; _i < 2; ++_i) \
        __builtin_amdgcn_global_load_lds((const unsigned*)((const char*)(gbase) + (voff)[_i]), (PG8_LAS unsigned*)(lds + (bufoff) + ldsw + _i * 8192), 16, 0, 0); } while (0)
#define PG8_LDA(dst, b, h) do { _Pragma("unroll") for (int m = 0; m < 4; ++m) _Pragma("unroll") for (int k = 0; k < 2; ++k) dst[m][k] = *(const PG8_LAS bf16x8*)(lds + PG8_SA(b, h) + aoff + m * 2048 + k * 1024); } while (0)
#define PG8_LDB(dst, b, h) do { _Pragma("unroll") for (int n = 0; n < 2; ++n) _Pragma("unroll") for (int k = 0; k < 2; ++k) dst[n][k] = *(const PG8_LAS bf16x8*)(lds + PG8_SB(b, h) + boff + n * 2048 + k * 1024); } while (0)
#define PG8_MMA(ai, bj, At, Bt) do { __builtin_amdgcn_s_setprio(1); _Pragma("unroll") for (int m = 0; m < 4; ++m) _Pragma("unroll") for (int n = 0; n < 2; ++n) _Pragma("unroll") for (int k = 0; k < 2; ++k) \
        acc[ai][bj][m][n] = __builtin_amdgcn_mfma_f32_16x16x32_bf16(Bt[n][k], At[m][k], acc[ai][bj][m][n], 0, 0, 0); __builtin_amdgcn_s_setprio(0); } while (0)
#define PG8_WAIT_V(n) asm volatile("s_waitcnt vmcnt(" #n ")" ::: "memory")
#define PG8_WAIT_L(n) asm volatile("s_waitcnt lgkmcnt(" #n ")" ::: "memory")
#define PG8_BAR __builtin_amdgcn_s_barrier()
#define PG8_SCHED __builtin_amdgcn_sched_barrier(0)
    Unit cur, nxt; int ui = 0;
    if (!S.next(0, cur)) return;
    f32x4 acc[2][2][4][2];
#pragma unroll
    for (int a = 0; a < 2; ++a)
#pragma unroll
        for (int b = 0; b < 2; ++b)
#pragma unroll
            for (int m = 0; m < 4; ++m)
#pragma unroll
                for (int n = 0; n < 2; ++n) acc[a][b][m][n] = (f32x4){0.f, 0.f, 0.f, 0.f};
    bf16x8 At[4][2], B0[2][2], B1[2][2];
    const char* cA = (const char*)g.A + (size_t)cur.pm * tstep; const char* cB = (const char*)g.Bt + (size_t)cur.pn * tstep;
    S.a_ready(cur);
    if constexpr (SP2) {
        PG8_STAGE(PG8_SB(0, 0), cB, voffB); PG8_STAGE(PG8_SB(0, 1), cB + hstep, voffB); PG8_STAGE(PG8_SA(0, 0), cA, voffA); PG8_STAGE(PG8_SA(0, 1), cA + hstep, voffA);
        if (wr == 1) PG8_BAR;
        PG8_WAIT_V(2); PG8_BAR;
        PG8_STAGE(PG8_SB(1, 0), cB + kstep, voffB); PG8_STAGE(PG8_SA(1, 0), cA + kstep, voffA); PG8_STAGE(PG8_SB(1, 1), cB + hstep + kstep, voffB);
        PG8_WAIT_V(6); PG8_BAR;
    } else {
        PG8_STAGE(PG8_SB(0, 0), cB, voffB); PG8_STAGE(PG8_SA(0, 0), cA, voffA); PG8_STAGE(PG8_SB(0, 1), cB + hstep, voffB); PG8_STAGE(PG8_SA(0, 1), cA + hstep, voffA);
        if (wr == 1) PG8_BAR;
        PG8_WAIT_V(4); PG8_BAR;
        PG8_STAGE(PG8_SB(1, 0), cB + kstep, voffB); PG8_STAGE(PG8_SA(1, 0), cA + kstep, voffA); PG8_STAGE(PG8_SB(1, 1), cB + hstep + kstep, voffB);
        PG8_WAIT_V(6); PG8_BAR;
    }
    for (;;) {
        const bool has_next = S.next(ui + 1, nxt);
        const char* nA = has_next ? (const char*)g.A + (size_t)nxt.pm * tstep : cA; const char* nB = has_next ? (const char*)g.Bt + (size_t)nxt.pn * tstep : cB;
        for (int t = 0; t < nt; t += 2) {
            const bool last = (t == nt - 2);
            const char* a1 = cA + (size_t)(t + 1) * kstep;
            const char* a2 = last ? nA : cA + (size_t)(t + 2) * kstep; const char* b2 = last ? nB : cB + (size_t)(t + 2) * kstep;
            const char* a3 = a2 + kstep; const char* b3 = b2 + kstep;
            if (last && has_next) S.a_ready(nxt);
            if constexpr (SP2) {
            PG8_LDB(B0, 0, 0); PG8_LDB(B1, 0, 1); PG8_SCHED; PG8_LDA(At, 0, 0); PG8_STAGE(PG8_SA(1, 1), a1 + hstep, voffA);
            PG8_WAIT_V(8); PG8_WAIT_L(0); PG8_BAR; PG8_MMA(0, 0, At, B0); PG8_MMA(0, 1, At, B1); PG8_BAR; PG8_SCHED;
            PG8_LDA(At, 0, 1); PG8_STAGE(PG8_SB(0, 0), b2, voffB); PG8_STAGE(PG8_SB(0, 1), b2 + hstep, voffB); PG8_STAGE(PG8_SA(0, 0), a2, voffA);
            PG8_WAIT_V(8); PG8_WAIT_L(0); PG8_BAR; PG8_MMA(1, 0, At, B0); PG8_MMA(1, 1, At, B1); PG8_BAR; PG8_SCHED;
            PG8_LDB(B0, 1, 0); PG8_LDB(B1, 1, 1); PG8_SCHED; PG8_LDA(At, 1, 0); PG8_STAGE(PG8_SA(0, 1), a2 + hstep, voffA);
            PG8_WAIT_V(8); PG8_WAIT_L(0); PG8_BAR; PG8_MMA(0, 0, At, B0); PG8_MMA(0, 1, At, B1); PG8_BAR; PG8_SCHED;
            PG8_LDA(At, 1, 1); PG8_STAGE(PG8_SB(1, 0), b3, voffB); PG8_STAGE(PG8_SB(1, 1), b3 + hstep, voffB); PG8_STAGE(PG8_SA(1, 0), a3, voffA);
            PG8_WAIT_V(8); PG8_WAIT_L(0); PG8_BAR; PG8_MMA(1, 0, At, B0); PG8_MMA(1, 1, At, B1); PG8_BAR; PG8_SCHED;
            } else {
            PG8_LDB(B0, 0, 0); PG8_SCHED; PG8_LDA(At, 0, 0); PG8_STAGE(PG8_SA(1, 1), a1 + hstep, voffA);
            PG8_WAIT_L(8); PG8_BAR; PG8_WAIT_L(0); PG8_MMA(0, 0, At, B0); PG8_BAR; PG8_SCHED;
            PG8_LDB(B1, 0, 1); PG8_STAGE(PG8_SB(0, 0), b2, voffB);
            PG8_BAR; PG8_WAIT_L(0); PG8_MMA(0, 1, At, B1); PG8_BAR;
            PG8_LDA(At, 0, 1); PG8_STAGE(PG8_SA(0, 0), a2, voffA);
            PG8_BAR; PG8_WAIT_L(0); PG8_MMA(1, 0, At, B0); PG8_BAR; PG8_SCHED;
            PG8_STAGE(PG8_SB(0, 1), b2 + hstep, voffB);
            PG8_WAIT_V(6); PG8_BAR; PG8_MMA(1, 1, At, B1); PG8_BAR;
            PG8_LDB(B0, 1, 0); PG8_SCHED; PG8_LDA(At, 1, 0); PG8_STAGE(PG8_SA(0, 1), a2 + hstep, voffA);
            PG8_WAIT_L(8); PG8_BAR; PG8_WAIT_L(0); PG8_MMA(0, 0, At, B0); PG8_BAR; PG8_SCHED;
            PG8_LDB(B1, 1, 1); PG8_STAGE(PG8_SB(1, 0), b3, voffB);
            PG8_BAR; PG8_WAIT_L(0); PG8_MMA(0, 1, At, B1); PG8_BAR;
            PG8_LDA(At, 1, 1); PG8_STAGE(PG8_SA(1, 0), a3, voffA);
            PG8_BAR; PG8_WAIT_L(0); PG8_MMA(1, 0, At, B0); PG8_BAR; PG8_SCHED;
            PG8_STAGE(PG8_SB(1, 1), b3 + hstep, voffB);
            PG8_WAIT_V(6); PG8_BAR; PG8_MMA(1, 1, At, B1); PG8_BAR;
            }
        }
        if constexpr (ALIGN_EPI) { if (wr == 0) PG8_BAR; }
        if constexpr (!Epi::AFTER_DRAIN) { E(acc, cur, wr, wc, fr, fq); S.done(cur); }
        if (!has_next) break;
#pragma unroll
        for (int a = 0; a < 2; ++a)
#pragma unroll
            for (int b = 0; b < 2; ++b)
#pragma unroll
                for (int m = 0; m < 4; ++m)
#pragma unroll
                    for (int n = 0; n < 2; ++n) acc[a][b][m][n] = (f32x4){0.f, 0.f, 0.f, 0.f};
        cur = nxt; cA = nA; cB = nB; ++ui;
        if constexpr (ALIGN_EPI) { if (wr == 1) PG8_BAR; }
    }
    PG8_WAIT_V(0);
    if constexpr (!ALIGN_EPI) { if (wr == 0) PG8_BAR; }
    PG8_BAR;
    if constexpr (Epi::AFTER_DRAIN) { E.fused(acc, cur, wr, wc, fr, fq, lds, wid, lane); S.done(cur); }
#undef PG8_SA
#undef PG8_SB
#undef PG8_STAGE
#undef PG8_LDA
#undef PG8_LDB
#undef PG8_MMA
#undef PG8_WAIT_V
#undef PG8_WAIT_L
#undef PG8_BAR
#undef PG8_SCHED
}

template <int ACT  > struct EpiBf16 {
    static constexpr bool PERM = true, AFTER_DRAIN = false;
    bf16_t* O; int ldc; int pad;
    __device__ __forceinline__ void operator()(const f32x4 (&acc)[2][2][4][2], const Unit& u, int wr, int wc, int fr, int fq) const {
        const int row0 = u.pm * BM + wr * 64 + fr, col0 = u.pn * BM + wc * 32 + 8 * fq;
#pragma unroll
        for (int ai = 0; ai < 2; ++ai)
#pragma unroll
            for (int m = 0; m < 4; ++m) { bf16_t* rowp = O + (size_t)(row0 + ai * HALF + m * 16) * ldc + col0;
#pragma unroll
                for (int bj = 0; bj < 2; ++bj) { f32x4 v0 = acc[ai][bj][m][0], v1 = acc[ai][bj][m][1];
                    if (ACT == 1) {
#pragma unroll
                        for (int j = 0; j < 4; ++j) { float a = v0[j] > 0.f ? v0[j] : 0.f, b = v1[j] > 0.f ? v1[j] : 0.f; v0[j] = a * a; v1[j] = b * b; } }
                    u32x4 w; w.x = cvt_pk_bf16(v0[0], v0[1]); w.y = cvt_pk_bf16(v0[2], v0[3]); w.z = cvt_pk_bf16(v1[0], v1[1]); w.w = cvt_pk_bf16(v1[2], v1[3]);
                    *(u32x4*)(rowp + bj * HALF) = w; } }
    }
};
struct EpiF32 {
    static constexpr bool PERM = true, AFTER_DRAIN = false;
    float* O; int ldc; int pad;
    __device__ __forceinline__ void operator()(const f32x4 (&acc)[2][2][4][2], const Unit& u, int wr, int wc, int fr, int fq) const {
        const int row0 = u.pm * BM + wr * 64 + fr, col0 = u.pn * BM + wc * 32 + 8 * fq;
#pragma unroll
        for (int ai = 0; ai < 2; ++ai)
#pragma unroll
            for (int m = 0; m < 4; ++m) { float* rowp = O + (size_t)(row0 + ai * HALF + m * 16) * ldc + col0;
#pragma unroll
                for (int bj = 0; bj < 2; ++bj) { *(f32x4*)(rowp + bj * HALF) = acc[ai][bj][m][0]; *(f32x4*)(rowp + bj * HALF + 4) = acc[ai][bj][m][1]; } }
    }
};
}

#define LAS __attribute__((address_space(3)))

struct Params {
  const float *x, *c, *w_ada, *b_ada, *pre_mix_w, *post_mix_w, *w_in, *dn_conv_w, *dn_a_log, *dn_dt_bias,
      *dn_norm_w, *sc_conv_w, *w_out, *pre_ffn_w, *post_ffn_w, *w_ff1, *w_ff2;
  float* out;
  unsigned char* ws;
};

__device__ __forceinline__ bf16_t f2bf(float x) {
  unsigned u = __float_as_uint(x);
  u += 0x7fffu + ((u >> 16) & 1u);
  return (bf16_t)(u >> 16);
}
__device__ __forceinline__ float bf2f(bf16_t b) { return __uint_as_float(((unsigned)b) << 16); }
typedef __bf16 bf16x2_t __attribute__((ext_vector_type(2)));
typedef float f32x2 __attribute__((ext_vector_type(2)));
__device__ __forceinline__ unsigned pack2(float lo, float hi) { f32x2 v = {lo, hi}; bf16x2_t r = __builtin_convertvector(v, bf16x2_t); return __builtin_bit_cast(unsigned, r); }
__device__ __forceinline__ float bflo(unsigned u) { return __uint_as_float(u << 16); }
__device__ __forceinline__ float bfhi(unsigned u) { return __uint_as_float(u & 0xffff0000u); }
__device__ __forceinline__ float siluf(float x) { return x / (1.f + __expf(-x)); }
__device__ __forceinline__ float sigmoidf_(float x) { return 1.f / (1.f + __expf(-x)); }
__device__ __forceinline__ float softplusf_(float x) { return x > 20.f ? x : log1pf(expf(x)); }

__device__ __forceinline__ int opaque_tid() { int t = threadIdx.x; asm volatile("" : "+v"(t)); return t; }

__device__ __forceinline__ float wave_sum(float v) {
#pragma unroll
  for (int o = 32; o >= 1; o >>= 1) v += __shfl_xor(v, o);
  return v;
}

__device__ __forceinline__ f32x4 load_mod4(const Params& P, int b, int col) {
  return *(const f32x4*)((const float*)(P.ws + WS_MODP) + (size_t)b * 6144 + col);
}

__device__ __forceinline__ void phase_mod(const Params& P, int bid, int nb, float* lds) {
  if (bid >= 96) return;
  const int t = opaque_tid(), kq = t >> 6, cl = t & 63;
  float* sc = lds;
  float* red = lds + 8192;
  for (int i = t; i < 8192; i += 512) sc[i] = siluf(P.c[i]);
  __syncthreads();
  for (int cg = bid; cg < 96; cg += nb) {
    float acc[8];
#pragma unroll
    for (int b = 0; b < 8; ++b) acc[b] = 0.f;
    const float* wp = P.w_ada + (size_t)(kq * 128) * 6144 + cg * 64 + cl;
#pragma unroll 8
    for (int k = 0; k < 128; ++k) {
      const float w = wp[(size_t)k * 6144];
#pragma unroll
      for (int b = 0; b < 8; ++b) acc[b] += sc[b * 1024 + kq * 128 + k] * w;
    }
#pragma unroll
    for (int b = 0; b < 8; ++b) red[(kq * 8 + b) * 64 + cl] = acc[b];
    __syncthreads();
    {
      const int b = t >> 6, c2 = t & 63;
      float sum = P.b_ada[cg * 64 + c2];
#pragma unroll
      for (int q = 0; q < 8; ++q) sum += red[(q * 8 + b) * 64 + c2];
      ((float*)(P.ws + WS_MODP))[(size_t)b * 6144 + cg * 64 + c2] = sum;
    }
    __syncthreads();
  }
}

__device__ __forceinline__ void transpose_item(const float* W, int ldw, int K, bf16_t* WT, LAS float* scr, int k0, int n0d, int n0s, int lane) {
#pragma unroll 8
  for (int i = 0; i < 32; ++i) { const int kk = 2 * i + (lane >> 5); scr[kk * 33 + (lane & 31)] = W[(size_t)(k0 + kk) * ldw + n0s + (lane & 31)]; }
  asm volatile("s_waitcnt lgkmcnt(0)" ::: "memory");
  const int c = lane & 7;
#pragma unroll
  for (int j = 0; j < 4; ++j) { const int n = (lane >> 3) + 8 * j; const LAS float* sp = scr + (8 * c) * 33 + n;
    u32x4 o; o.x = pack2(sp[0 * 33], sp[1 * 33]); o.y = pack2(sp[2 * 33], sp[3 * 33]); o.z = pack2(sp[4 * 33], sp[5 * 33]); o.w = pack2(sp[6 * 33], sp[7 * 33]);
    *(u32x4*)(WT + (size_t)(n0d + n) * K + k0 + 8 * c) = o; }
  asm volatile("s_waitcnt lgkmcnt(0)" ::: "memory");
}
constexpr int CV_IN = 16 * 112, CV_OUT = 16 * 32, CV_FF1 = 16 * 128, CV_FF2 = 64 * 32, CV_ITEMS = CV_IN + CV_OUT + CV_FF1 + CV_FF2;
__device__ __forceinline__ void phase_convert(const Params& P, int gw, int ngw, LAS float* scr, int lane) {
  for (int it = gw; it < CV_ITEMS; it += ngw) {
    int r = it;
    if (r < CV_IN) { const int kb = r / 112, nb = r % 112, n0 = 32 * nb; transpose_item(P.w_in, DIN, D, (bf16_t*)(P.ws + WS_WT_IN), scr, 64 * kb, n0, n0 + (n0 >= 2048 ? 8 : 0), lane); continue; } r -= CV_IN;
    if (r < CV_OUT) { const int kb = r / 32, nb = r % 32; transpose_item(P.w_out, D, D, (bf16_t*)(P.ws + WS_WT_OUT), scr, 64 * kb, 32 * nb, 32 * nb, lane); continue; } r -= CV_OUT;
    if (r < CV_FF1) { const int kb = r / 128, nb = r % 128; transpose_item(P.w_ff1, DFF, D, (bf16_t*)(P.ws + WS_WT_FF1), scr, 64 * kb, 32 * nb, 32 * nb, lane); continue; } r -= CV_FF1;
    { const int kb = r / 32, nb = r % 32; transpose_item(P.w_ff2, D, DFF, (bf16_t*)(P.ws + WS_WT_FF2), scr, 64 * kb, 32 * nb, 32 * nb, lane); }
  }
}

__device__ __forceinline__ float reduce8(float (&pa)[8], int lane) {
  float q[4], r2[2];
#pragma unroll
  for (int i = 0; i < 4; ++i) { const float send = (lane & 32) ? pa[i] : pa[i + 4], keep = (lane & 32) ? pa[i + 4] : pa[i]; q[i] = keep + __shfl_xor(send, 32); }
#pragma unroll
  for (int i = 0; i < 2; ++i) { const float send = (lane & 16) ? q[i] : q[i + 2], keep = (lane & 16) ? q[i + 2] : q[i]; r2[i] = keep + __shfl_xor(send, 16); }
  const float send = (lane & 8) ? r2[0] : r2[1], keep = (lane & 8) ? r2[1] : r2[0];
  float v = keep + __shfl_xor(send, 8);
  v += __shfl_xor(v, 4); v += __shfl_xor(v, 2); v += __shfl_xor(v, 1);
  return v;
}
__device__ __forceinline__ void phase_prenorm(const Params& P, int bid, int nb, LAS unsigned char* lds) {
  const int t = opaque_tid(), wv = t >> 6, lane = t & 63;
  const int rpw = M / (nb * 8), row0 = (bid * 8 + wv) * rpw, b = row0 / SEQ;
  bf16_t* H = (bf16_t*)(P.ws + WS_H);
  float* G = (float*)(P.ws + WS_G);
  float* BETA = (float*)(P.ws + WS_BETA);
  LAS f32x4* wa = (LAS f32x4*)lds;
  LAS f32x4* wb = (LAS f32x4*)(lds + 16384);
  __syncthreads();
  for (int k = t; k < 1024; k += 512) {
    const int slot = (((k >> 8) * 4 + (k & 3)) * 64) + ((k & 255) >> 2);
    wa[slot] = *(const f32x4*)(P.w_in + (size_t)k * DIN + 2048);
    wb[slot] = *(const f32x4*)(P.w_in + (size_t)k * DIN + 2052);
  }
  f32x4 mulv[4], shv[4];
#pragma unroll
  for (int j = 0; j < 4; ++j) {
    const int col = 4 * lane + 256 * j;
    shv[j] = load_mod4(P, b, 0 * D + col);
    mulv[j] = *(const f32x4*)(P.pre_mix_w + col) * (load_mod4(P, b, 1 * D + col) + 1.0f);
  }
  const float alog = P.dn_a_log[(lane >> 3) & 3], dtb = P.dn_dt_bias[(lane >> 3) & 3];
  __syncthreads();
  for (int it = 0; it < rpw; it += 2) {
    f32x4 xv[2][4];
#pragma unroll
    for (int u = 0; u < 2; ++u)
#pragma unroll
      for (int j = 0; j < 4; ++j) xv[u][j] = *(const f32x4*)(P.x + (size_t)(row0 + it + u) * D + 4 * lane + 256 * j);
#pragma unroll
    for (int u = 0; u < 2; ++u) {
      const int row = row0 + it + u;
      float ss = 0.f;
#pragma unroll
      for (int j = 0; j < 4; ++j) ss += xv[u][j][0] * xv[u][j][0] + xv[u][j][1] * xv[u][j][1] + xv[u][j][2] * xv[u][j][2] + xv[u][j][3] * xv[u][j][3];
      const float rstd = rsqrtf(wave_sum(ss) * (1.0f / D) + EPS);
      float pa[8];
#pragma unroll
      for (int i = 0; i < 8; ++i) pa[i] = 0.f;
#pragma unroll
      for (int j = 0; j < 4; ++j) {
        const f32x4 hv = xv[u][j] * rstd * mulv[j] + shv[j];
        u32x2 pk; pk[0] = pack2(hv[0], hv[1]); pk[1] = pack2(hv[2], hv[3]);
        *(u32x2*)(H + (size_t)row * D + 4 * lane + 256 * j) = pk;
#pragma unroll
        for (int e = 0; e < 4; ++e) {
          const f32x4 a4 = wa[(j * 4 + e) * 64 + lane], b4 = wb[(j * 4 + e) * 64 + lane];
          pa[0] += hv[e] * a4[0]; pa[1] += hv[e] * a4[1]; pa[2] += hv[e] * a4[2]; pa[3] += hv[e] * a4[3];
          pa[4] += hv[e] * b4[0]; pa[5] += hv[e] * b4[1]; pa[6] += hv[e] * b4[2]; pa[7] += hv[e] * b4[3];
        }
      }
      const float v = reduce8(pa, lane);
      if ((lane & 7) == 0) {
        const int idx = lane >> 3;
        if (idx < 4) G[(size_t)row * 4 + idx] = -expf(alog) * softplusf_(v + dtb);
        else BETA[(size_t)row * 4 + (idx - 4)] = sigmoidf_(v);
      }
    }
  }
}

typedef short bf16x8 __attribute__((ext_vector_type(8)));
typedef float f32x16 __attribute__((ext_vector_type(16)));
#define MFMA32(a, b, c) __builtin_amdgcn_mfma_f32_32x32x16_bf16((a), (b), (c), 0, 0, 0)
__device__ __forceinline__ int crow(int reg, int hh) { return (reg & 3) + 8 * (reg >> 2) + 4 * hh; }
__device__ __forceinline__ int swap23(int k) { return (k & ~12) | ((k & 4) << 1) | ((k & 8) >> 1); }
template <int S_> __device__ __forceinline__ bf16x8 pack_step(const f32x16& x) {
  u32x4 p; p[0] = pack2(x[8 * S_ + 0], x[8 * S_ + 1]); p[1] = pack2(x[8 * S_ + 2], x[8 * S_ + 3]); p[2] = pack2(x[8 * S_ + 4], x[8 * S_ + 5]); p[3] = pack2(x[8 * S_ + 6], x[8 * S_ + 7]);
  return __builtin_bit_cast(bf16x8, p);
}
__device__ __forceinline__ f32x16 zero16() { f32x16 z;
#pragma unroll
  for (int i = 0; i < 16; ++i) z[i] = 0.f;
  return z; }

constexpr int PA_QS = 0, PA_KS = 17408, PA_KT = 34816, PA_VT = 53248, PA_AM = 71680, PA_T1 = 89088, PA_T2 = 98304, PA_GC = 107520, PA_BETA = 107776, PA_TL = 108032, PA_KDS = 117248;
constexpr float QSCALE = 0.08838834764831845f;
__device__ __forceinline__ void phase_chunk_prep(const Params& P, int ci, LAS unsigned char* lds) {
  const int bh = ci >> 5, n = ci & 31, b = bh >> 2, h = bh & 3;
  const int t = opaque_tid(), w = __builtin_amdgcn_readfirstlane(t >> 6);
  int lane = t & 63, r = lane & 31, hh = lane >> 5;
#define OPAQUE_LANE() do { asm volatile("" : "+v"(lane)); r = lane & 31; hh = lane >> 5; } while (0)
  const bf16_t* PROJ = (const bf16_t*)(P.ws + WS_PROJ);
  const size_t row0 = (size_t)b * SEQ + n * 64;
  LAS float* gcs = (LAS float*)(lds + PA_GC);
  LAS float* betas = (LAS float*)(lds + PA_BETA);
  LAS float* Am = (LAS float*)(lds + PA_AM);
  __syncthreads();
  float gc = ((const float*)(P.ws + WS_G))[(row0 + lane) * 4 + h];
  const float betal = ((const float*)(P.ws + WS_BETA))[(row0 + lane) * 4 + h];
#pragma unroll
  for (int o = 1; o < 64; o <<= 1) { const float v = __shfl_up(gc, o); if (lane >= o) gc += v; }
  const float glast = __shfl(gc, 63);
  if (w == 0) { gcs[lane] = gc; betas[lane] = betal; if (lane == 63) ((float*)(P.ws + WS_GL))[ci] = __expf(gc); }
  OPAQUE_LANE();
  {
    const int t0 = 8 * w, colb = h * HD + 2 * lane;
    float cw[4][3][2];
#pragma unroll
    for (int j = 0; j < 4; ++j)
#pragma unroll
      for (int p = 0; p < 3; ++p) { const f32x2 v2 = *(const f32x2*)(P.dn_conv_w + j * 1536 + p * 512 + colb); cw[j][p][0] = v2[0]; cw[j][p][1] = v2[1]; }
    unsigned raw[11][3];
#pragma unroll
    for (int rr = 0; rr < 11; ++rr) {
      const int tk = n * 64 + t0 - 3 + rr;
#pragma unroll
      for (int p = 0; p < 3; ++p) raw[rr][p] = tk >= 0 ? *(const unsigned*)(PROJ + ((size_t)b * SEQ + tk) * DP + p * 512 + colb) : 0u;
    }
    bf16_t* QG = (bf16_t*)(P.ws + WS_QG);
#pragma unroll
    for (int tt = 0; tt < 8; ++tt) {
      float c[3][2];
#pragma unroll
      for (int p = 0; p < 3; ++p) {
        float a0 = 0.f, a1 = 0.f;
#pragma unroll
        for (int j = 0; j < 4; ++j) { a0 += cw[j][p][0] * bflo(raw[tt + j][p]); a1 += cw[j][p][1] * bfhi(raw[tt + j][p]); }
        c[p][0] = siluf(a0); c[p][1] = siluf(a1);
      }
      const float rq = rsqrtf(wave_sum(c[0][0] * c[0][0] + c[0][1] * c[0][1]) + EPS) * QSCALE;
      const float rk = rsqrtf(wave_sum(c[1][0] * c[1][0] + c[1][1] * c[1][1]) + EPS);
      const float q0 = c[0][0] * rq, q1 = c[0][1] * rq, k0 = c[1][0] * rk, k1 = c[1][1] * rk;
      const int tok = t0 + tt;
      const float gct = __shfl(gc, tok);
      const float egc = __expf(gct), ekd = __expf(glast - gct);
      *(LAS unsigned*)(lds + PA_QS + tok * 272 + 4 * lane) = pack2(q0, q1);
      const unsigned kp = pack2(k0, k1), vp = pack2(c[2][0], c[2][1]), dp = pack2(k0 * ekd, k1 * ekd);
      *(LAS unsigned*)(lds + PA_KS + tok * 272 + 4 * lane) = kp;
      *(unsigned*)(QG + ((size_t)ci * 64 + tok) * 128 + swap23(2 * lane)) = pack2(q0 * egc, q1 * egc);
      *(LAS bf16_t*)(lds + PA_KT + (2 * lane) * 144 + tok * 2) = (bf16_t)(kp & 0xffffu);
      *(LAS bf16_t*)(lds + PA_KT + (2 * lane + 1) * 144 + tok * 2) = (bf16_t)(kp >> 16);
      *(LAS bf16_t*)(lds + PA_VT + (2 * lane) * 144 + tok * 2) = (bf16_t)(vp & 0xffffu);
      *(LAS bf16_t*)(lds + PA_VT + (2 * lane + 1) * 144 + tok * 2) = (bf16_t)(vp >> 16);
      *(LAS bf16_t*)(lds + PA_KDS + (2 * lane) * 144 + tok * 2) = (bf16_t)(dp & 0xffffu);
      *(LAS bf16_t*)(lds + PA_KDS + (2 * lane + 1) * 144 + tok * 2) = (bf16_t)(dp >> 16);
    }
  }
  __syncthreads();
  OPAQUE_LANE();
  if (w < 3) {
    const int ti = (w >= 1) ? 1 : 0, tj = (w == 2) ? 1 : 0;
    f32x16 acc = zero16();
#pragma unroll
    for (int ks = 0; ks < 8; ++ks) {
      const bf16x8 a = *(const LAS bf16x8*)(lds + PA_KS + (32 * ti + r) * 272 + (16 * ks + 8 * hh) * 2);
      const bf16x8 bb = *(const LAS bf16x8*)(lds + PA_KS + (32 * tj + r) * 272 + (16 * ks + 8 * hh) * 2);
      acc = MFMA32(a, bb, acc);
    }
    const int j = 32 * tj + r; const float gcj = gcs[j];
#pragma unroll
    for (int reg = 0; reg < 16; ++reg) {
      const int i = 32 * ti + crow(reg, hh);
      const float dec = __expf(fminf(gcs[i] - gcj, 0.f));
      Am[i * 68 + j] = (i > j) ? betas[i] * acc[reg] * dec : 0.f;
    }
  } else if (w < 7) {
    const int idx = w - 3, tj = (idx >= 2) ? 1 : 0, ti = (idx == 1 || idx == 2) ? 1 : 0;
    f32x16 acc = zero16();
    if (!(tj == 1 && ti == 0)) {
#pragma unroll
      for (int ks = 0; ks < 8; ++ks) {
        const bf16x8 a = *(const LAS bf16x8*)(lds + PA_KS + (32 * tj + r) * 272 + (16 * ks + 8 * hh) * 2);
        const bf16x8 bb = *(const LAS bf16x8*)(lds + PA_QS + (32 * ti + r) * 272 + (16 * ks + 8 * hh) * 2);
        acc = MFMA32(a, bb, acc);
      }
    }
    const int i = 32 * ti + r; const float gci = gcs[i];
    f32x16 x;
#pragma unroll
    for (int reg = 0; reg < 16; ++reg) {
      const int j = 32 * tj + crow(reg, hh);
      const float dec = __expf(fminf(gci - gcs[j], 0.f));
      x[reg] = (i >= j) ? acc[reg] * dec : 0.f;
    }
    bf16_t* ATT = (bf16_t*)(P.ws + WS_ATT) + ((size_t)ci * 64 + i) * 64 + 32 * tj + 8 * hh;
    *(bf16x8*)(ATT) = pack_step<0>(x);
    *(bf16x8*)(ATT + 16) = pack_step<1>(x);
  } else {
    bf16_t* KD = (bf16_t*)(P.ws + WS_KD) + (size_t)ci * 128 * 64;
#pragma unroll 4
    for (int it = 0; it < 16; ++it) {
      const int idx = it * 64 + lane, dk = idx >> 3, pp = idx & 7;
      const u32x2 lo = *(const LAS u32x2*)(lds + PA_KDS + dk * 144 + swap23(8 * pp) * 2);
      const u32x2 hi = *(const LAS u32x2*)(lds + PA_KDS + dk * 144 + swap23(8 * pp + 4) * 2);
      u32x4 o; o[0] = lo[0]; o[1] = lo[1]; o[2] = hi[0]; o[3] = hi[1];
      *(u32x4*)(KD + dk * 64 + 8 * pp) = o;
    }
  }
  __syncthreads();
  OPAQUE_LANE();
  if (w == 0) {
    const int d = hh, c = r;
    LAS float* TL = (LAS float*)(lds + PA_TL);
    const LAS float* Ad = Am + (32 * d) * 68 + 32 * d;
    float T[32];
#pragma unroll
    for (int i = 0; i < 32; ++i) {
      float acc = (c == i) ? 1.f : 0.f;
#pragma unroll
      for (int j = 0; j < i; ++j) acc -= Ad[i * 68 + j] * T[j];
      T[i] = acc;
    }
#pragma unroll
    for (int i = 0; i < 32; ++i) TL[(32 * d + i) * 36 + c] = T[i];
    f32x16 X = zero16(), Y = zero16();
#pragma unroll
    for (int ks = 0; ks < 16; ++ks) X = __builtin_amdgcn_mfma_f32_32x32x2f32(Am[(32 + r) * 68 + 2 * ks + hh], TL[(2 * ks + hh) * 36 + r], X, 0, 0, 0);
#pragma unroll
    for (int s2 = 0; s2 < 16; ++s2) Y = __builtin_amdgcn_mfma_f32_32x32x2f32(TL[(32 + r) * 36 + crow(s2, hh)], X[s2], Y, 0, 0, 0);
    {
      const float bc = betas[32 * d + c], bg = -bc * __expf(gcs[32 * d + c]);
#pragma unroll
      for (int i = 0; i < 32; ++i) {
        *(LAS bf16_t*)(lds + PA_T1 + (32 * d + i) * 144 + 2 * (32 * d + c)) = (bf16_t)(pack2(T[i] * bc, 0.f) & 0xffffu);
        *(LAS bf16_t*)(lds + PA_T2 + (32 * d + i) * 144 + 2 * (32 * d + c)) = (bf16_t)(pack2(T[i] * bg, 0.f) & 0xffffu);
      }
    }
    {
      const float bc = betas[r], bg = -bc * __expf(gcs[r]);
#pragma unroll
      for (int reg = 0; reg < 16; ++reg) {
        const int i = crow(reg, hh);
        *(LAS bf16_t*)(lds + PA_T1 + (32 + i) * 144 + 2 * r) = (bf16_t)(pack2(-Y[reg] * bc, 0.f) & 0xffffu);
        *(LAS bf16_t*)(lds + PA_T2 + (32 + i) * 144 + 2 * r) = (bf16_t)(pack2(-Y[reg] * bg, 0.f) & 0xffffu);
        *(LAS bf16_t*)(lds + PA_T1 + i * 144 + 2 * (32 + r)) = (bf16_t)0;
        *(LAS bf16_t*)(lds + PA_T2 + i * 144 + 2 * (32 + r)) = (bf16_t)0;
      }
    }
  }
  __syncthreads();
  OPAQUE_LANE();
  {
    const int mt = w >> 2, nt = w & 3;
    f32x16 acc = zero16();
#pragma unroll
    for (int ks = 0; ks < 4; ++ks) {
      const bf16x8 a = *(const LAS bf16x8*)(lds + PA_T1 + (32 * mt + r) * 144 + (16 * ks + 8 * hh) * 2);
      const bf16x8 bb = *(const LAS bf16x8*)(lds + PA_VT + (32 * nt + r) * 144 + (16 * ks + 8 * hh) * 2);
      acc = MFMA32(a, bb, acc);
    }
    float* U = (float*)(P.ws + WS_U) + ((((size_t)ci * 4 + nt) * 2 + mt) * 4) * 256 + lane * 4;
#pragma unroll
    for (int q = 0; q < 4; ++q) { f32x4 v4 = {acc[4 * q], acc[4 * q + 1], acc[4 * q + 2], acc[4 * q + 3]}; *(f32x4*)(U + q * 256) = v4; }
    const int dt = w >> 1, it = w & 1;
    f32x16 acc2 = zero16();
#pragma unroll
    for (int ks = 0; ks < 4; ++ks) {
      const bf16x8 a = *(const LAS bf16x8*)(lds + PA_KT + (32 * dt + r) * 144 + (16 * ks + 8 * hh) * 2);
      const bf16x8 bb = *(const LAS bf16x8*)(lds + PA_T2 + (32 * it + r) * 144 + (16 * ks + 8 * hh) * 2);
      acc2 = MFMA32(a, bb, acc2);
    }
    bf16_t* WN = (bf16_t*)(P.ws + WS_WN) + ((size_t)ci * 64 + 32 * it + r) * 128 + 32 * dt + 8 * hh;
    *(bf16x8*)(WN) = pack_step<0>(acc2);
    *(bf16x8*)(WN + 16) = pack_step<1>(acc2);
  }
}

constexpr int SC_WN = 0, SC_QG = 17408, SC_KD = 34816, SC_ATT = 53248, SC_U = 62464, SC_SLOT = 70656;
__device__ __forceinline__ void scan_piece(int p, int ci, int dvs, const unsigned char* ws, const unsigned char*& src, int& dst) {
  if (p < 1024) { src = ws + WS_WN + (size_t)ci * 16384 + p * 16; dst = SC_WN + (p >> 4) * 272 + (p & 15) * 16; }
  else if (p < 2048) { const int q = p - 1024; src = ws + WS_QG + (size_t)ci * 16384 + q * 16; dst = SC_QG + (q >> 4) * 272 + (q & 15) * 16; }
  else if (p < 3072) { const int q = p - 2048; src = ws + WS_KD + (size_t)ci * 16384 + q * 16; dst = SC_KD + (q >> 3) * 144 + (q & 7) * 16; }
  else if (p < 3584) { const int q = p - 3072; src = ws + WS_ATT + (size_t)ci * 8192 + q * 16; dst = SC_ATT + (q >> 3) * 144 + (q & 7) * 16; }
  else { const int q = p - 3584; src = ws + WS_U + ((size_t)ci * 4 + dvs) * 8192 + q * 16; dst = SC_U + q * 16; }
}
#define SCAN_BAR() do { asm volatile("s_waitcnt lgkmcnt(0)" ::: "memory"); __builtin_amdgcn_s_barrier(); asm volatile("" ::: "memory"); } while (0)
__device__ __forceinline__ void phase_scan(const Params& P, int item, LAS unsigned char* lds) {
  const int bh = item >> 2, dvs = item & 3, b = bh >> 2, h = bh & 3;
  const int t = opaque_tid(), w = __builtin_amdgcn_readfirstlane(t >> 6), lane = t & 63, r = lane & 31, hh = lane >> 5;
  const int ci0 = bh * 32, ltid = t - 64;
  const unsigned char* ws = P.ws;
  __syncthreads();
  if (w > 0) {
    u32x4 R[10];
#pragma unroll
    for (int k = 0; k < 10; ++k) { const int p = ltid + 448 * k; if (p < 4096) { const unsigned char* src; int dst; scan_piece(p, ci0, dvs, ws, src, dst); R[k] = *(const u32x4*)src; } }
#pragma unroll
    for (int k = 0; k < 10; ++k) { const int p = ltid + 448 * k; if (p < 4096) { const unsigned char* src; int dst; scan_piece(p, ci0, dvs, ws, src, dst); *(LAS u32x4*)(lds + dst) = R[k]; } }
#pragma unroll
    for (int k = 0; k < 10; ++k) { const int p = ltid + 448 * k; if (p < 4096) { const unsigned char* src; int dst; scan_piece(p, ci0 + 1, dvs, ws, src, dst); R[k] = *(const u32x4*)src; } }
    SCAN_BAR();
    for (int n = 0; n < 32; ++n) {
      if (n + 1 < 32) {
        const int so = ((n + 1) & 1) * SC_SLOT;
#pragma unroll
        for (int k = 0; k < 10; ++k) { const int p = ltid + 448 * k; if (p < 4096) { const unsigned char* src; int dst; scan_piece(p, ci0, dvs, ws, src, dst); *(LAS u32x4*)(lds + so + dst) = R[k]; } }
      }
      if (n + 2 < 32) {
#pragma unroll
        for (int k = 0; k < 10; ++k) { const int p = ltid + 448 * k; if (p < 4096) { const unsigned char* src; int dst; scan_piece(p, ci0 + n + 2, dvs, ws, src, dst); R[k] = *(const u32x4*)src; } }
      }
      SCAN_BAR();
    }
  } else {
    f32x16 S[4];
#pragma unroll
    for (int kt = 0; kt < 4; ++kt) S[kt] = zero16();
    const float egl_all = ((const float*)(ws + WS_GL))[ci0 + (lane & 31)];
    SCAN_BAR();
    for (int n = 0; n < 32; ++n) {
      const LAS unsigned char* sl = lds + (n & 1) * SC_SLOT;
      const float egl = __builtin_bit_cast(float, __builtin_amdgcn_readlane(__builtin_bit_cast(int, egl_all), n));
      bf16x8 Sb[8];
      Sb[0] = pack_step<0>(S[0]); Sb[1] = pack_step<1>(S[0]); Sb[2] = pack_step<0>(S[1]); Sb[3] = pack_step<1>(S[1]);
      Sb[4] = pack_step<0>(S[2]); Sb[5] = pack_step<1>(S[2]); Sb[6] = pack_step<0>(S[3]); Sb[7] = pack_step<1>(S[3]);
      f32x16 av[2], ao[2];
#pragma unroll
      for (int mt = 0; mt < 2; ++mt) {
#pragma unroll
        for (int q = 0; q < 4; ++q) { const f32x4 uq = *(const LAS f32x4*)(sl + SC_U + ((mt * 4 + q) * 64 + lane) * 16); av[mt][4 * q] = uq[0]; av[mt][4 * q + 1] = uq[1]; av[mt][4 * q + 2] = uq[2]; av[mt][4 * q + 3] = uq[3]; }
        ao[mt] = zero16();
      }
#pragma unroll
      for (int mt = 0; mt < 2; ++mt)
#pragma unroll
        for (int ks = 0; ks < 8; ++ks) {
          const bf16x8 a = *(const LAS bf16x8*)(sl + SC_WN + (32 * mt + r) * 272 + (16 * ks + 8 * hh) * 2);
          av[mt] = MFMA32(a, Sb[ks], av[mt]);
        }
#pragma unroll
      for (int mt = 0; mt < 2; ++mt)
#pragma unroll
        for (int ks = 0; ks < 8; ++ks) {
          const bf16x8 a = *(const LAS bf16x8*)(sl + SC_QG + (32 * mt + r) * 272 + (16 * ks + 8 * hh) * 2);
          ao[mt] = MFMA32(a, Sb[ks], ao[mt]);
        }
      bf16x8 Vb[4];
      Vb[0] = pack_step<0>(av[0]); Vb[1] = pack_step<1>(av[0]); Vb[2] = pack_step<0>(av[1]); Vb[3] = pack_step<1>(av[1]);
#pragma unroll
      for (int mt = 0; mt < 2; ++mt)
#pragma unroll
        for (int ks = 0; ks < 4; ++ks) {
          const bf16x8 a = *(const LAS bf16x8*)(sl + SC_ATT + (32 * mt + r) * 144 + (16 * ks + 8 * hh) * 2);
          ao[mt] = MFMA32(a, Vb[ks], ao[mt]);
        }
#pragma unroll
      for (int kt = 0; kt < 4; ++kt) {
        S[kt] = S[kt] * egl;
#pragma unroll
        for (int ks = 0; ks < 4; ++ks) {
          const bf16x8 a = *(const LAS bf16x8*)(sl + SC_KD + (32 * kt + r) * 144 + (16 * ks + 8 * hh) * 2);
          S[kt] = MFMA32(a, Vb[ks], S[kt]);
        }
      }
      bf16_t* O = (bf16_t*)(P.ws + WS_O) + ((size_t)b * SEQ + n * 64) * 512 + h * HD + 32 * dvs + r;
#pragma unroll
      for (int mt = 0; mt < 2; ++mt)
#pragma unroll
        for (int reg = 0; reg < 16; ++reg) O[(size_t)(32 * mt + crow(reg, hh)) * 512] = (bf16_t)(pack2(ao[mt][reg], 0.f) & 0xffffu);
      SCAN_BAR();
    }
  }
  __syncthreads();
}

__device__ __forceinline__ void unpack8(const u32x4& v, float (&f)[8]) {
#pragma unroll
  for (int i = 0; i < 4; ++i) { f[2 * i] = bflo(v[i]); f[2 * i + 1] = bfhi(v[i]); }
}
__device__ __forceinline__ void phase_gate_mix(const Params& P, int bid, int nb) {
  const int t = opaque_tid(), wv = t >> 6, lane = t & 63;
  const int rpw = M / (nb * 8), row0 = (bid * 8 + wv) * rpw;
  const bf16_t* PROJ = (const bf16_t*)(P.ws + WS_PROJ);
  const bf16_t* O = (const bf16_t*)(P.ws + WS_O);
  bf16_t* MIX = (bf16_t*)(P.ws + WS_MIX);
  const int col = 8 * lane;
  float nw[8], cw[3][8];
  { const f32x4 n0 = *(const f32x4*)(P.dn_norm_w + (col & 127)), n1 = *(const f32x4*)(P.dn_norm_w + (col & 127) + 4);
#pragma unroll
    for (int i = 0; i < 4; ++i) { nw[i] = n0[i]; nw[4 + i] = n1[i]; } }
#pragma unroll
  for (int j = 0; j < 3; ++j) { const f32x4 c0 = *(const f32x4*)(P.sc_conv_w + j * 512 + col), c1 = *(const f32x4*)(P.sc_conv_w + j * 512 + col + 4);
#pragma unroll
    for (int i = 0; i < 4; ++i) { cw[j][i] = c0[i]; cw[j][4 + i] = c1[i]; } }
  float pm2[8], pm1[8];
  {
    const int tk0 = row0 % SEQ;
    float cf[8], hf[8];
    if (tk0 >= 2) { unpack8(*(const u32x4*)(PROJ + (size_t)(row0 - 2) * DP + OFF_SC + col), cf); unpack8(*(const u32x4*)(PROJ + (size_t)(row0 - 2) * DP + OFF_SH + col), hf);
#pragma unroll
      for (int i = 0; i < 8; ++i) pm2[i] = cf[i] * hf[i]; }
    else {
#pragma unroll
      for (int i = 0; i < 8; ++i) pm2[i] = 0.f; }
    if (tk0 >= 1) { unpack8(*(const u32x4*)(PROJ + (size_t)(row0 - 1) * DP + OFF_SC + col), cf); unpack8(*(const u32x4*)(PROJ + (size_t)(row0 - 1) * DP + OFF_SH + col), hf);
#pragma unroll
      for (int i = 0; i < 8; ++i) pm1[i] = cf[i] * hf[i]; }
    else {
#pragma unroll
      for (int i = 0; i < 8; ++i) pm1[i] = 0.f; }
  }
  for (int it = 0; it < rpw; it += 2) {
    u32x4 ov[2], zv[2], bv[2], cv[2], hv[2];
#pragma unroll
    for (int u = 0; u < 2; ++u) {
      const size_t row = row0 + it + u;
      ov[u] = *(const u32x4*)(O + row * 512 + col);
      zv[u] = *(const u32x4*)(PROJ + row * DP + OFF_Z + col);
      bv[u] = *(const u32x4*)(PROJ + row * DP + OFF_SB + col);
      cv[u] = *(const u32x4*)(PROJ + row * DP + OFF_SC + col);
      hv[u] = *(const u32x4*)(PROJ + row * DP + OFF_SH + col);
    }
#pragma unroll
    for (int u = 0; u < 2; ++u) {
      const size_t row = row0 + it + u;
      float o[8], z[8], sb[8], sc[8], sh[8];
      unpack8(ov[u], o); unpack8(zv[u], z); unpack8(bv[u], sb); unpack8(cv[u], sc); unpack8(hv[u], sh);
      float ss = 0.f;
#pragma unroll
      for (int i = 0; i < 8; ++i) ss += o[i] * o[i];
      ss += __shfl_xor(ss, 8); ss += __shfl_xor(ss, 4); ss += __shfl_xor(ss, 2); ss += __shfl_xor(ss, 1);
      const float rstd = rsqrtf(ss * (1.0f / HD) + EPS);
      u32x4 r1, r2;
#pragma unroll
      for (int i = 0; i < 4; ++i) r1[i] = pack2(o[2 * i] * rstd * nw[2 * i] * siluf(z[2 * i]), o[2 * i + 1] * rstd * nw[2 * i + 1] * siluf(z[2 * i + 1]));
      *(u32x4*)(MIX + row * D + col) = r1;
      float y[8];
#pragma unroll
      for (int i = 0; i < 8; ++i) { const float p0 = sc[i] * sh[i]; y[i] = sb[i] * (cw[0][i] * pm2[i] + cw[1][i] * pm1[i] + cw[2][i] * p0); pm2[i] = pm1[i]; pm1[i] = p0; }
#pragma unroll
      for (int i = 0; i < 4; ++i) r2[i] = pack2(y[2 * i], y[2 * i + 1]);
      *(u32x4*)(MIX + row * D + 512 + col) = r2;
    }
  }
}

__device__ __forceinline__ void phase_post1(const Params& P, int bid, int nb) {
  const int t = opaque_tid(), wv = t >> 6, lane = t & 63;
  const int rpw = M / (nb * 8), row0 = (bid * 8 + wv) * rpw, b = row0 / SEQ;
  const bf16_t* Y = (const bf16_t*)(P.ws + WS_Y);
  bf16_t* H2 = (bf16_t*)(P.ws + WS_H2);
  f32x4 m1[4], m2[4], shf[4];
#pragma unroll
  for (int j = 0; j < 4; ++j) {
    const int col = 4 * lane + 256 * j;
    m1[j] = load_mod4(P, b, 2 * D + col) * *(const f32x4*)(P.post_mix_w + col);
    m2[j] = *(const f32x4*)(P.pre_ffn_w + col) * (load_mod4(P, b, 4 * D + col) + 1.0f);
    shf[j] = load_mod4(P, b, 3 * D + col);
  }
  for (int it = 0; it < rpw; it += 2) {
    f32x4 xv[2][4]; u32x2 yr[2][4];
#pragma unroll
    for (int u = 0; u < 2; ++u)
#pragma unroll
      for (int j = 0; j < 4; ++j) { xv[u][j] = *(const f32x4*)(P.x + (size_t)(row0 + it + u) * D + 4 * lane + 256 * j); yr[u][j] = *(const u32x2*)(Y + (size_t)(row0 + it + u) * D + 4 * lane + 256 * j); }
#pragma unroll
    for (int u = 0; u < 2; ++u) {
      const size_t row = row0 + it + u;
      f32x4 yv[4]; float ss = 0.f;
#pragma unroll
      for (int j = 0; j < 4; ++j) { yv[j][0] = bflo(yr[u][j][0]); yv[j][1] = bfhi(yr[u][j][0]); yv[j][2] = bflo(yr[u][j][1]); yv[j][3] = bfhi(yr[u][j][1]);
        ss += yv[j][0] * yv[j][0] + yv[j][1] * yv[j][1] + yv[j][2] * yv[j][2] + yv[j][3] * yv[j][3]; }
      const float rstd = rsqrtf(wave_sum(ss) * (1.0f / D) + EPS);
      f32x4 x1[4]; float ss2 = 0.f;
#pragma unroll
      for (int j = 0; j < 4; ++j) { x1[j] = xv[u][j] + yv[j] * rstd * m1[j]; *(f32x4*)(P.out + row * D + 4 * lane + 256 * j) = x1[j];
        ss2 += x1[j][0] * x1[j][0] + x1[j][1] * x1[j][1] + x1[j][2] * x1[j][2] + x1[j][3] * x1[j][3]; }
      const float rstd2 = rsqrtf(wave_sum(ss2) * (1.0f / D) + EPS);
#pragma unroll
      for (int j = 0; j < 4; ++j) { const f32x4 hv = x1[j] * rstd2 * m2[j] + shf[j]; u32x2 pk; pk[0] = pack2(hv[0], hv[1]); pk[1] = pack2(hv[2], hv[3]);
        *(u32x2*)(H2 + row * D + 4 * lane + 256 * j) = pk; }
    }
  }
}

__device__ __forceinline__ void phase_final(const Params& P, int bid, int nb) {
  const int t = opaque_tid(), wv = t >> 6, lane = t & 63;
  const int rpw = M / (nb * 8), row0 = (bid * 8 + wv) * rpw, b = row0 / SEQ;
  const bf16_t* Y2 = (const bf16_t*)(P.ws + WS_Y2);
  f32x4 m1[4];
#pragma unroll
  for (int j = 0; j < 4; ++j) { const int col = 4 * lane + 256 * j; m1[j] = load_mod4(P, b, 5 * D + col) * *(const f32x4*)(P.post_ffn_w + col); }
  for (int it = 0; it < rpw; it += 2) {
    f32x4 xv[2][4]; u32x2 yr[2][4];
#pragma unroll
    for (int u = 0; u < 2; ++u)
#pragma unroll
      for (int j = 0; j < 4; ++j) { xv[u][j] = *(const f32x4*)(P.out + (size_t)(row0 + it + u) * D + 4 * lane + 256 * j); yr[u][j] = *(const u32x2*)(Y2 + (size_t)(row0 + it + u) * D + 4 * lane + 256 * j); }
#pragma unroll
    for (int u = 0; u < 2; ++u) {
      const size_t row = row0 + it + u;
      f32x4 yv[4]; float ss = 0.f;
#pragma unroll
      for (int j = 0; j < 4; ++j) { yv[j][0] = bflo(yr[u][j][0]); yv[j][1] = bfhi(yr[u][j][0]); yv[j][2] = bflo(yr[u][j][1]); yv[j][3] = bfhi(yr[u][j][1]);
        ss += yv[j][0] * yv[j][0] + yv[j][1] * yv[j][1] + yv[j][2] * yv[j][2] + yv[j][3] * yv[j][3]; }
      const float rstd = rsqrtf(wave_sum(ss) * (1.0f / D) + EPS);
#pragma unroll
      for (int j = 0; j < 4; ++j) *(f32x4*)(P.out + row * D + 4 * lane + 256 * j) = xv[u][j] + yv[j] * rstd * m1[j];
    }
  }
}

#define XB_TMO      128
#define XB_XCNT(j)  (256  + 64 * (j))
#define XB_XSUB(j)  (1280 + 64 * (j))
#define XB_XGEN(j)  (2304 + 64 * (j))
#define XB_TOP      3328
#define XB_TOPGEN   3392
#define XCD_BAR_WORDS 3456
#define XB_SPIN_CAP (1u << 18)

__device__ __forceinline__ unsigned xb_ld(unsigned* p)              { return __hip_atomic_load(p, __ATOMIC_RELAXED, __HIP_MEMORY_SCOPE_AGENT); }
__device__ __forceinline__ unsigned xb_add(unsigned* p, unsigned v) { return __hip_atomic_fetch_add(p, v, __ATOMIC_RELAXED, __HIP_MEMORY_SCOPE_AGENT); }
__device__ __forceinline__ unsigned xb_xcc_id() { return (unsigned)__builtin_amdgcn_s_getreg((3 << 11) | 20) & 0xFu; }
#define XB_SPIN(cond, bar) do { unsigned _sp = 0; while (cond) { __builtin_amdgcn_s_sleep(1); \
    if ((++_sp & 255u) == 0u) { if (xb_ld(&(bar)[XB_TMO])) break; if (_sp > XB_SPIN_CAP) { atomicAdd(&(bar)[XB_TMO], 1u); break; } } } } while (0)

struct XcdBarrier {
    unsigned* bar; unsigned x;
    volatile LAS unsigned* st;
};

__device__ __forceinline__ XcdBarrier xcd_barrier_post(unsigned* bar, volatile LAS unsigned* st) {
    XcdBarrier b; b.bar = bar; b.x = xb_xcc_id(); b.st = st;
    if (threadIdx.x == 0) (void)xb_add(&bar[XB_XCNT(b.x)], 1u);
    return b;
}
__device__ __forceinline__ void xcd_barrier_complete(unsigned* bar, unsigned x, unsigned& nloc, unsigned& nx) {
    const unsigned G = gridDim.x * gridDim.y * gridDim.z;
    unsigned sum, cnt, mine, sp = 0u;
    for (;;) {
        sum = 0u; cnt = 0u; mine = 0u;
#pragma unroll
        for (unsigned j = 0; j < 16; ++j) { const unsigned c = xb_ld(&bar[XB_XCNT(j)]); sum += c; cnt += (c > 0u) ? 1u : 0u; mine = (j == x) ? c : mine; }
        if (sum == G) break;
        __builtin_amdgcn_s_sleep(1);
        if ((++sp & 255u) == 0u) { if (xb_ld(&bar[XB_TMO])) break; if (sp > XB_SPIN_CAP) { atomicAdd(&bar[XB_TMO], 1u); break; } }
    }
    nloc = mine > 0u ? mine : 1u; nx = cnt > 0u ? cnt : 1u;
}

__device__ __forceinline__ void xcd_barrier(const XcdBarrier& b) {
    asm volatile("s_waitcnt vmcnt(0)" ::: "memory");
    __syncthreads();
    if (threadIdx.x == 0) {
        unsigned* bar = b.bar;
        __builtin_amdgcn_s_waitcnt(0);
        unsigned nloc = b.st[0], nx = b.st[1];
        if (nloc == 0u) { xcd_barrier_complete(bar, b.x, nloc, nx); b.st[0] = nloc; b.st[1] = nx; }
        const unsigned old = xb_add(&bar[XB_XSUB(b.x)], 1u);
        const unsigned gen = old / nloc;
        if (old + 1u == (gen + 1u) * nloc) {
            __builtin_amdgcn_fence(__ATOMIC_RELEASE, "agent");
            asm volatile("s_waitcnt vmcnt(0)" ::: "memory");
            const unsigned og = xb_add(&bar[XB_TOP], 1u);
            const unsigned tg = og / nx;
            if (og + 1u == (tg + 1u) * nx) xb_add(&bar[XB_TOPGEN], 1u);
            else XB_SPIN(xb_ld(&bar[XB_TOPGEN]) == tg, bar);
            __builtin_amdgcn_fence(__ATOMIC_ACQUIRE, "agent");
            xb_add(&bar[XB_XGEN(b.x)], 1u);
            asm volatile("s_waitcnt vmcnt(0)" ::: "memory");
        } else {
            XB_SPIN(xb_ld(&bar[XB_XGEN(b.x)]) == gen, bar);
            __builtin_amdgcn_fence(__ATOMIC_ACQUIRE, "agent");
            asm volatile("s_waitcnt vmcnt(0)" ::: "memory");
        }
    }
    __syncthreads();
}

__global__ void __launch_bounds__(512, 2) k_mega(Params P) {
  __shared__ __attribute__((aligned(16))) unsigned char lds[2 * SC_SLOT + 64];
  cg::grid_group grid = cg::this_grid();
  const int bid = blockIdx.x, nb = gridDim.x, wv = threadIdx.x >> 6, lane = threadIdx.x & 63;
  unsigned char* ws = P.ws;
  volatile LAS unsigned* bst = (volatile LAS unsigned*)((LAS unsigned char*)lds + 2 * SC_SLOT);
  if (threadIdx.x < 2) bst[threadIdx.x] = 0u;
  __syncthreads();
  XcdBarrier xbar = xcd_barrier_post((unsigned*)(ws + WS_BAR), bst);
  phase_mod(P, bid, nb, (float*)lds);
  __syncthreads();
  phase_convert(P, bid * 8 + wv, nb * 8, (LAS float*)lds + wv * 2112, lane);
  grid.sync();
  phase_prenorm(P, bid, nb, (LAS unsigned char*)lds);
  xcd_barrier(xbar);
  { pg8::Gemm g{(const bf16_t*)(ws + WS_H), (const bf16_t*)(ws + WS_WT_IN), M, DP, D}; pg8::StaticOrder S; S.init(M, DP, nb, bid);
    pg8::EpiBf16<0> E{(bf16_t*)(ws + WS_PROJ), DP, 0};
    pg8::gemm_phase<pg8::EpiBf16<0>, pg8::StaticOrder, true, true>((PG8_LAS unsigned char*)lds, g, S, E); }
  xcd_barrier(xbar);
  for (int ci = bid; ci < 1024; ci += nb) phase_chunk_prep(P, ci, (LAS unsigned char*)lds);
  xcd_barrier(xbar);
  for (int it = bid; it < 128; it += nb) phase_scan(P, it, (LAS unsigned char*)lds);
  xcd_barrier(xbar);
  phase_gate_mix(P, bid, nb);
  xcd_barrier(xbar);
  { pg8::Gemm g{(const bf16_t*)(ws + WS_MIX), (const bf16_t*)(ws + WS_WT_OUT), M, D, D}; pg8::StaticOrder S; S.init(M, D, nb, bid);
    pg8::EpiBf16<0> E{(bf16_t*)(ws + WS_Y), D, 0};
    pg8::gemm_phase<pg8::EpiBf16<0>, pg8::StaticOrder, true, true>((PG8_LAS unsigned char*)lds, g, S, E); }
  xcd_barrier(xbar);
  phase_post1(P, bid, nb);
  xcd_barrier(xbar);
  { pg8::Gemm g{(const bf16_t*)(ws + WS_H2), (const bf16_t*)(ws + WS_WT_FF1), M, DFF, D}; pg8::StaticOrder S; S.init(M, DFF, nb, bid);
    pg8::EpiBf16<1> E{(bf16_t*)(ws + WS_HID), DFF, 0};
    pg8::gemm_phase<pg8::EpiBf16<1>, pg8::StaticOrder, true, true>((PG8_LAS unsigned char*)lds, g, S, E); }
  xcd_barrier(xbar);
  { pg8::Gemm g{(const bf16_t*)(ws + WS_HID), (const bf16_t*)(ws + WS_WT_FF2), M, D, DFF}; pg8::StaticOrder S; S.init(M, D, nb, bid);
    pg8::EpiBf16<0> E{(bf16_t*)(ws + WS_Y2), D, 0};
    pg8::gemm_phase<pg8::EpiBf16<0>, pg8::StaticOrder, true, true>((PG8_LAS unsigned char*)lds, g, S, E); }
  xcd_barrier(xbar);
  phase_final(P, bid, nb);
}

extern "C" void kernel_launch(void* const* d_in, const int* in_sizes, int n_in, void* d_out, int out_size, void* d_ws, size_t ws_size,
                              hipStream_t stream) {
  static int grid_blocks = 0;
  if (!grid_blocks) {
    int dev = 0, cus = 0, per_cu = 0;
    hipGetDevice(&dev);
    hipDeviceGetAttribute(&cus, hipDeviceAttributeMultiprocessorCount, dev);
    hipOccupancyMaxActiveBlocksPerMultiprocessor(&per_cu, (const void*)k_mega, 512, 0);
    if (per_cu < 1) per_cu = 1;
    grid_blocks = cus * per_cu;
    if (grid_blocks > 256) grid_blocks = 256;
    if (grid_blocks < 256) { int g = 1; while (g * 2 <= grid_blocks) g *= 2; grid_blocks = g; }
  }
  Params P{};
  P.x = (const float*)d_in[0]; P.c = (const float*)d_in[1]; P.w_ada = (const float*)d_in[2]; P.b_ada = (const float*)d_in[3];
  P.pre_mix_w = (const float*)d_in[4]; P.post_mix_w = (const float*)d_in[5]; P.w_in = (const float*)d_in[6];
  P.dn_conv_w = (const float*)d_in[7]; P.dn_a_log = (const float*)d_in[8]; P.dn_dt_bias = (const float*)d_in[9];
  P.dn_norm_w = (const float*)d_in[10]; P.sc_conv_w = (const float*)d_in[11]; P.w_out = (const float*)d_in[12];
  P.pre_ffn_w = (const float*)d_in[13]; P.post_ffn_w = (const float*)d_in[14]; P.w_ff1 = (const float*)d_in[15];
  P.w_ff2 = (const float*)d_in[16];
  P.out = (float*)d_out; P.ws = (unsigned char*)d_ws;
  (void)hipMemsetAsync((unsigned char*)d_ws + WS_BAR, 0, 16384, stream);
  void* args[] = {&P};
  hipError_t e = hipLaunchCooperativeKernel((const void*)k_mega, dim3(grid_blocks), dim3(512), args, 0, stream);
  if (e != hipSuccess) fprintf(stderr, "cooperative launch failed: %s (grid %d)\n", hipGetErrorString(e), grid_blocks);
}

#ifdef PHASE_TEST
__global__ void __launch_bounds__(512, 2) k_t_prep(Params P) { __shared__ __attribute__((aligned(16))) unsigned char lds[2 * SC_SLOT]; for (int ci = blockIdx.x; ci < 1024; ci += gridDim.x) phase_chunk_prep(P, ci, (LAS unsigned char*)lds); }
__global__ void __launch_bounds__(512, 2) k_t_scan(Params P) { __shared__ __attribute__((aligned(16))) unsigned char lds[2 * SC_SLOT]; for (int it = blockIdx.x; it < 128; it += gridDim.x) phase_scan(P, it, (LAS unsigned char*)lds); }
__global__ void __launch_bounds__(512, 2) k_t_pre(Params P) { __shared__ __attribute__((aligned(16))) unsigned char lds[2 * SC_SLOT]; phase_prenorm(P, blockIdx.x, gridDim.x, (LAS unsigned char*)lds); }
#endif
```

```cpp
#include <hip/hip_runtime.h>
#include <hip/hip_bf16.h>
#include <hip/hip_cooperative_groups.h>
#include <stdint.h>
#include <cstdio>
namespace cg = cooperative_groups;

typedef unsigned short bf16_t;
typedef float f32x4 __attribute__((ext_vector_type(4)));
typedef unsigned u32x2 __attribute__((ext_vector_type(2)));
typedef unsigned u32x4 __attribute__((ext_vector_type(4)));

constexpr int D = 1024, NB = 8, SEQ = 2048, M = NB * SEQ, DIN = 3592, DP = 3584, DFF = 4096;
constexpr int NH = 4, HD = 128;
constexpr float EPS = 1e-6f;
constexpr int OFF_Q = 0, OFF_K = 512, OFF_V = 1024, OFF_Z = 1536, OFF_SB = 2048, OFF_SC = 2560, OFF_SH = 3072;
constexpr int MOD_KS = 4;

constexpr size_t MiB = 1ull << 20;
constexpr size_t WS_WT_IN = 0, WS_WT_OUT = 7 * MiB, WS_WT_FF1 = 9 * MiB, WS_WT_FF2 = 17 * MiB;
constexpr size_t WS_MODP = 25 * MiB;
constexpr size_t WS_G = 25 * MiB + 768 * 1024;
constexpr size_t WS_BETA = 26 * MiB;
constexpr size_t WS_PROJ = 27 * MiB;
constexpr size_t WS_H = 139 * MiB;
constexpr size_t WS_GL = 26 * MiB + 256 * 1024;
constexpr size_t WS_BAR = 26 * MiB + 512 * 1024;
constexpr size_t WS_QG = 139 * MiB;
constexpr size_t WS_KD = 155 * MiB;
constexpr size_t WS_WN = 171 * MiB;
constexpr size_t WS_ATT = 187 * MiB;
constexpr size_t WS_U = 195 * MiB;
constexpr size_t WS_O = 227 * MiB;
constexpr size_t WS_MIX = 139 * MiB;
constexpr size_t WS_Y = 27 * MiB;
constexpr size_t WS_HID = 27 * MiB;
constexpr size_t WS_H2 = 160 * MiB;
constexpr size_t WS_Y2 = 192 * MiB;

namespace pg8 {
#define PG8_LAS __attribute__((address_space(3)))
typedef unsigned short bf16_t;
typedef short bf16x8 __attribute__((ext_vector_type(8)));
typedef float f32x4 __attribute__((ext_vector_type(4)));
typedef unsigned u32x4 __attribute__((ext_vector_type(4)));
constexpr int BM = 256, BK = 64, HALF = 128, HTB = HALF * BK * 2  , STAGE_BYTES = 8 * HTB, NXCD = 8, WGM = 8;

__host__ __device__ __forceinline__ int lds_byte(int r, int c) { const int st = (r >> 4) * 2 + (c >> 5), rr = r & 15, cc = c & 31, ob = rr * 64 + cc * 2; return st * 1024 + (ob ^ (((ob >> 9) & 1) << 5)); }
__host__ __device__ __forceinline__ void stage_rc(int b, int& R, int& C) { const int st = b / 1024, sb = b % 1024, swz = sb ^ (((sb >> 9) & 1) << 5); R = (st >> 1) * 16 + swz / 64; C = (st & 1) * 32 + (swz % 64) / 2; }
__host__ __device__ __forceinline__ int perm32(int rho) { const int n = rho >> 4, i = rho & 15; return 8 * (i >> 2) + 4 * n + (i & 3); }

struct Unit { int pm, pn; };
struct Gemm { const bf16_t* A; const bf16_t* Bt; int M, N, K; };

struct StaticOrder {
    int nM, nN, nwg, G, c;
    __host__ __device__ void init(int M, int N, int G_, int c_) { nM = M / BM; nN = N / BM; nwg = nM * nN; G = G_; c = c_; }
    __host__ __device__ bool next(int i, Unit& u) const {
        const long L = (long)i * G + c; if (L >= nwg) return false;
        int wgid = (int)L; { const int q = nwg / NXCD, r = nwg % NXCD, xcd = wgid % NXCD, off = wgid / NXCD; wgid = (xcd < r ? xcd * (q + 1) : r * (q + 1) + (xcd - r) * q) + off; }
        const int nig = WGM * nN, gid = wgid / nig, fm = gid * WGM, gsz = (nM - fm) < WGM ? (nM - fm) : WGM;
        u.pm = fm + ((wgid % nig) % gsz); u.pn = (wgid % nig) / gsz; return true;
    }
    __device__ __forceinline__ void a_ready(const Unit&) const {}
    __device__ __forceinline__ void done(const Unit&) const {}
};

__device__ __forceinline__ unsigned cvt_pk_bf16(float lo, float hi) { unsigned r; asm volatile("v_cvt_pk_bf16_f32 %0, %1, %2" : "=v"(r) : "v"(lo), "v"(hi)); return r; }
template <class Epi, class Sched, bool ALIGN_EPI = false, bool SP2 = false>
__device__ __forceinline__ void gemm_phase(PG8_LAS unsigned char* lds, const Gemm g, const Sched& S, const Epi& E) {
    int tid_ = threadIdx.x; asm volatile("" : "+v"(tid_));
    const int tid = tid_, wid = __builtin_amdgcn_readfirstlane(tid >> 6), lane = tid & 63, wr = wid >> 2, wc = wid & 3, fr = lane & 15, fq = lane >> 4;
    const int K = g.K, nt = K / BK;
    unsigned voffA[2], voffB[2];
#pragma unroll
    for (int i = 0; i < 2; ++i) { int R, C; stage_rc(tid * 16 + i * 8192, R, C); const int Rb = Epi::PERM ? ((R & ~31) + perm32(R & 31)) : R;
        voffA[i] = (unsigned)(R * K + C) * 2u; voffB[i] = (unsigned)(Rb * K + C) * 2u; }
    const size_t kstep = (size_t)(BK * 2);
    const size_t hstep = (size_t)HALF * K * 2;
    const size_t tstep = 2 * hstep;
    const unsigned ldsw = (unsigned)wid * 1024u;
    const int aoff = lds_byte(wr * 64 + fr, fq * 8), boff = lds_byte(wc * 32 + fr, fq * 8);
#define PG8_SA(b, h) (((b) * 2 + (h)) * HTB)
#define PG8_SB(b, h) ((4 + (b) * 2 + (h)) * HTB)
#define PG8_STAGE(bufoff, gbase, voff) do { _Pragma("unroll") for (int _i = 0; _i < 2; ++_i) \
        __builtin_amdgcn_global_load_lds((const unsigned*)((const char*)(gbase) + (voff)[_i]), (PG8_LAS unsigned*)(lds + (bufoff) + ldsw + _i * 8192), 16, 0, 0); } while (0)
#define PG8_LDA(dst, b, h) do { _Pragma("unroll") for (int m = 0; m < 4; ++m) _Pragma("unroll") for (int k = 0; k < 2; ++k) dst[m][k] = *(const PG8_LAS bf16x8*)(lds + PG8_SA(b, h) + aoff + m * 2048 + k * 1024); } while (0)
#define PG8_LDB(dst, b, h) do { _Pragma("unroll") for (int n = 0; n < 2; ++n) _Pragma("unroll") for (int k = 0; k < 2; ++k) dst[n][k] = *(const PG8_LAS bf16x8*)(lds + PG8_SB(b, h) + boff + n * 2048 + k * 1024); } while (0)
#define PG8_MMA(ai, bj, At, Bt) do { __builtin_amdgcn_s_setprio(1); _Pragma("unroll") for (int m = 0; m < 4; ++m) _Pragma("unroll") for (int n = 0; n < 2; ++n) _Pragma("unroll") for (int k = 0; k < 2; ++k) \
        acc[ai][bj][m][n] = __builtin_amdgcn_mfma_f32_16x16x32_bf16(Bt[n][k], At[m][k], acc[ai][bj][m][n], 0, 0, 0); __builtin_amdgcn_s_setprio(0); } while (0)
#define PG8_WAIT_V(n) asm volatile("s_waitcnt vmcnt(" #n ")" ::: "memory")
#define PG8_WAIT_L(n) asm volatile("s_waitcnt lgkmcnt(" #n ")" ::: "memory")
#define PG8_BAR __builtin_amdgcn_s_barrier()
#define PG8_SCHED __builtin_amdgcn_sched_barrier(0)
    Unit cur, nxt; int ui = 0;
    if (!S.next(0, cur)) return;
    f32x4 acc[2][2][4][2];
#pragma unroll
    for (int a = 0; a < 2; ++a)
#pragma unroll
        for (int b = 0; b < 2; ++b)
#pragma unroll
            for (int m = 0; m < 4; ++m)
#pragma unroll
                for (int n = 0; n < 2; ++n) acc[a][b][m][n] = (f32x4){0.f, 0.f, 0.f, 0.f};
    bf16x8 At[4][2], B0[2][2], B1[2][2];
    const char* cA = (const char*)g.A + (size_t)cur.pm * tstep; const char* cB = (const char*)g.Bt + (size_t)cur.pn * tstep;
    S.a_ready(cur);
    if constexpr (SP2) {
        PG8_STAGE(PG8_SB(0, 0), cB, voffB); PG8_STAGE(PG8_SB(0, 1), cB + hstep, voffB); PG8_STAGE(PG8_SA(0, 0), cA, voffA); PG8_STAGE(PG8_SA(0, 1), cA + hstep, voffA);
        if (wr == 1) PG8_BAR;
        PG8_WAIT_V(2); PG8_BAR;
        PG8_STAGE(PG8_SB(1, 0), cB + kstep, voffB); PG8_STAGE(PG8_SA(1, 0), cA + kstep, voffA); PG8_STAGE(PG8_SB(1, 1), cB + hstep + kstep, voffB);
        PG8_WAIT_V(6); PG8_BAR;
    } else {
        PG8_STAGE(PG8_SB(0, 0), cB, voffB); PG8_STAGE(PG8_SA(0, 0), cA, voffA); PG8_STAGE(PG8_SB(0, 1), cB + hstep, voffB); PG8_STAGE(PG8_SA(0, 1), cA + hstep, voffA);
        if (wr == 1) PG8_BAR;
        PG8_WAIT_V(4); PG8_BAR;
        PG8_STAGE(PG8_SB(1, 0), cB + kstep, voffB); PG8_STAGE(PG8_SA(1, 0), cA + kstep, voffA); PG8_STAGE(PG8_SB(1, 1), cB + hstep + kstep, voffB);
        PG8_WAIT_V(6); PG8_BAR;
    }
    for (;;) {
        const bool has_next = S.next(ui + 1, nxt);
        const char* nA = has_next ? (const char*)g.A + (size_t)nxt.pm * tstep : cA; const char* nB = has_next ? (const char*)g.Bt + (size_t)nxt.pn * tstep : cB;
        for (int t = 0; t < nt; t += 2) {
            const bool last = (t == nt - 2);
            const char* a1 = cA + (size_t)(t + 1) * kstep;
            const char* a2 = last ? nA : cA + (size_t)(t + 2) * kstep; const char* b2 = last ? nB : cB + (size_t)(t + 2) * kstep;
            const char* a3 = a2 + kstep; const char* b3 = b2 + kstep;
            if (last && has_next) S.a_ready(nxt);
            if constexpr (SP2) {
            PG8_LDB(B0, 0, 0); PG8_LDB(B1, 0, 1); PG8_SCHED; PG8_LDA(At, 0, 0); PG8_STAGE(PG8_SA(1, 1), a1 + hstep, voffA);
            PG8_WAIT_V(8); PG8_WAIT_L(0); PG8_BAR; PG8_MMA(0, 0, At, B0); PG8_MMA(0, 1, At, B1); PG8_BAR; PG8_SCHED;
            PG8_LDA(At, 0, 1); PG8_STAGE(PG8_SB(0, 0), b2, voffB); PG8_STAGE(PG8_SB(0, 1), b2 + hstep, voffB); PG8_STAGE(PG8_SA(0, 0), a2, voffA);
            PG8_WAIT_V(8); PG8_WAIT_L(0); PG8_BAR; PG8_MMA(1, 0, At, B0); PG8_MMA(1, 1, At, B1); PG8_BAR; PG8_SCHED;
            PG8_LDB(B0, 1, 0); PG8_LDB(B1, 1, 1); PG8_SCHED; PG8_LDA(At, 1, 0); PG8_STAGE(PG8_SA(0, 1), a2 + hstep, voffA);
            PG8_WAIT_V(8); PG8_WAIT_L(0); PG8_BAR; PG8_MMA(0, 0, At, B0); PG8_MMA(0, 1, At, B1); PG8_BAR; PG8_SCHED;
            PG8_LDA(At, 1, 1); PG8_STAGE(PG8_SB(1, 0), b3, voffB); PG8_STAGE(PG8_SB(1, 1), b3 + hstep, voffB); PG8_STAGE(PG8_SA(1, 0), a3, voffA);
            PG8_WAIT_V(8); PG8_WAIT_L(0); PG8_BAR; PG8_MMA(1, 0, At, B0); PG8_MMA(1, 1, At, B1); PG8_BAR; PG8_SCHED;
            } else {
            PG8_LDB(B0, 0, 0); PG8_SCHED; PG8_LDA(At, 0, 0); PG8_STAGE(PG8_SA(1, 1), a1 + hstep, voffA);
            PG8_WAIT_L(8); PG8_BAR; PG8_WAIT_L(0); PG8_MMA(0, 0, At, B0); PG8_BAR; PG8_SCHED;
            PG8_LDB(B1, 0, 1); PG8_STAGE(PG8_SB(0, 0), b2, voffB);
            PG8_BAR; PG8_WAIT_L(0); PG8_MMA(0, 1, At, B1); PG8_BAR;
            PG8_LDA(At, 0, 1); PG8_STAGE(PG8_SA(0, 0), a2, voffA);
            PG8_BAR; PG8_WAIT_L(0); PG8_MMA(1, 0, At, B0); PG8_BAR; PG8_SCHED;
            PG8_STAGE(PG8_SB(0, 1), b2 + hstep, voffB);
            PG8_WAIT_V(6); PG8_BAR; PG8_MMA(1, 1, At, B1); PG8_BAR;
            PG8_LDB(B0, 1, 0); PG8_SCHED; PG8_LDA(At, 1, 0); PG8_STAGE(PG8_SA(0, 1), a2 + hstep, voffA);
            PG8_WAIT_L(8); PG8_BAR; PG8_WAIT_L(0); PG8_MMA(0, 0, At, B0); PG8_BAR; PG8_SCHED;
            PG8_LDB(B1, 1, 1); PG8_STAGE(PG8_SB(1, 0), b3, voffB);
            PG8_BAR; PG8_WAIT_L(0); PG8_MMA(0, 1, At, B1); PG8_BAR;
            PG8_LDA(At, 1, 1); PG8_STAGE(PG8_SA(1, 0), a3, voffA);
            PG8_BAR; PG8_WAIT_L(0); PG8_MMA(1, 0, At, B0); PG8_BAR; PG8_SCHED;
            PG8_STAGE(PG8_SB(1, 1), b3 + hstep, voffB);
            PG8_WAIT_V(6); PG8_BAR; PG8_MMA(1, 1, At, B1); PG8_BAR;
            }
        }
        if constexpr (ALIGN_EPI) { if (wr == 0) PG8_BAR; }
        if constexpr (!Epi::AFTER_DRAIN) { E(acc, cur, wr, wc, fr, fq); S.done(cur); }
        if (!has_next) break;
#pragma unroll
        for (int a = 0; a < 2; ++a)
#pragma unroll
            for (int b = 0; b < 2; ++b)
#pragma unroll
                for (int m = 0; m < 4; ++m)
#pragma unroll
                    for (int n = 0; n < 2; ++n) acc[a][b][m][n] = (f32x4){0.f, 0.f, 0.f, 0.f};
        cur = nxt; cA = nA; cB = nB; ++ui;
        if constexpr (ALIGN_EPI) { if (wr == 1) PG8_BAR; }
    }
    PG8_WAIT_V(0);
    if constexpr (!ALIGN_EPI) { if (wr == 0) PG8_BAR; }
    PG8_BAR;
    if constexpr (Epi::AFTER_DRAIN) { E.fused(acc, cur, wr, wc, fr, fq, lds, wid, lane); S.done(cur); }
#undef PG8_SA
#undef PG8_SB
#undef PG8_STAGE
#undef PG8_LDA
#undef PG8_LDB
#undef PG8_MMA
#undef PG8_WAIT_V
#undef PG8_WAIT_L
#undef PG8_BAR
#undef PG8_SCHED
}

template <int ACT  > struct EpiBf16 {
    static constexpr bool PERM = true, AFTER_DRAIN = false;
    bf16_t* O; int ldc; int pad;
    __device__ __forceinline__ void operator()(const f32x4 (&acc)[2][2][4][2], const Unit& u, int wr, int wc, int fr, int fq) const {
        const int row0 = u.pm * BM + wr * 64 + fr, col0 = u.pn * BM + wc * 32 + 8 * fq;
#pragma unroll
        for (int ai = 0; ai < 2; ++ai)
#pragma unroll
            for (int m = 0; m < 4; ++m) { bf16_t* rowp = O + (size_t)(row0 + ai * HALF + m * 16) * ldc + col0;
#pragma unroll
                for (int bj = 0; bj < 2; ++bj) { f32x4 v0 = acc[ai][bj][m][0], v1 = acc[ai][bj][m][1];
                    if (ACT == 1) {
#pragma unroll
                        for (int j = 0; j < 4; ++j) { float a = v0[j] > 0.f ? v0[j] : 0.f, b = v1[j] > 0.f ? v1[j] : 0.f; v0[j] = a * a; v1[j] = b * b; } }
                    u32x4 w; w.x = cvt_pk_bf16(v0[0], v0[1]); w.y = cvt_pk_bf16(v0[2], v0[3]); w.z = cvt_pk_bf16(v1[0], v1[1]); w.w = cvt_pk_bf16(v1[2], v1[3]);
                    *(u32x4*)(rowp + bj * HALF) = w; } }
    }
};
struct EpiF32 {
    static constexpr bool PERM = true, AFTER_DRAIN = false;
    float* O; int ldc; int pad;
    __device__ __forceinline__ void operator()(const f32x4 (&acc)[2][2][4][2], const Unit& u, int wr, int wc, int fr, int fq) const {
        const int row0 = u.pm * BM + wr * 64 + fr, col0 = u.pn * BM + wc * 32 + 8 * fq;
#pragma unroll
        for (int ai = 0; ai < 2; ++ai)
#pragma unroll
            for (int m = 0; m < 4; ++m) { float* rowp = O + (size_t)(row0 + ai * HALF + m * 16) * ldc + col0;
#pragma unroll
                for (int bj = 0; bj < 2; ++bj) { *(f32x4*)(rowp + bj * HALF) = acc[ai][bj][m][0]; *(f32x4*)(rowp + bj * HALF + 4) = acc[ai][bj][m][1]; } }
    }
};
}

#define LAS __attribute__((address_space(3)))

struct Params {
  const float *x, *c, *w_ada, *b_ada, *pre_mix_w, *post_mix_w, *w_in, *dn_conv_w, *dn_a_log, *dn_dt_bias,
      *dn_norm_w, *sc_conv_w, *w_out, *pre_ffn_w, *post_ffn_w, *w_ff1, *w_ff2;
  float* out;
  unsigned char* ws;
};

__device__ __forceinline__ bf16_t f2bf(float x) {
  unsigned u = __float_as_uint(x);
  u += 0x7fffu + ((u >> 16) & 1u);
  return (bf16_t)(u >> 16);
}
__device__ __forceinline__ float bf2f(bf16_t b) { return __uint_as_float(((unsigned)b) << 16); }
typedef __bf16 bf16x2_t __attribute__((ext_vector_type(2)));
typedef float f32x2 __attribute__((ext_vector_type(2)));
__device__ __forceinline__ unsigned pack2(float lo, float hi) { f32x2 v = {lo, hi}; bf16x2_t r = __builtin_convertvector(v, bf16x2_t); return __builtin_bit_cast(unsigned, r); }
__device__ __forceinline__ float bflo(unsigned u) { return __uint_as_float(u << 16); }
__device__ __forceinline__ float bfhi(unsigned u) { return __uint_as_float(u & 0xffff0000u); }
__device__ __forceinline__ float siluf(float x) { return x * __builtin_amdgcn_rcpf(1.f + __expf(-x)); }
__device__ __forceinline__ float sigmoidf_(float x) { return __builtin_amdgcn_rcpf(1.f + __expf(-x)); }
__device__ __forceinline__ float softplusf_(float x) { return x > 20.f ? x : log1pf(expf(x)); }

__device__ __forceinline__ int opaque_tid() { int t = threadIdx.x; asm volatile("" : "+v"(t)); return t; }

template <int CTRL> __device__ __forceinline__ float dpp_mov(float v) {
  return __builtin_bit_cast(float, __builtin_amdgcn_update_dpp(0, __builtin_bit_cast(int, v), CTRL, 0xf, 0xf, false));
}
__device__ __forceinline__ float row16_sum(float v) {
  v += dpp_mov<0xB1>(v); v += dpp_mov<0x4E>(v); v += dpp_mov<0x141>(v); v += dpp_mov<0x140>(v);
  return v;
}
__device__ __forceinline__ float wave_sum(float v) {
  v = row16_sum(v);
  const float a = __builtin_bit_cast(float, __builtin_amdgcn_readlane(__builtin_bit_cast(int, v), 0));
  const float b = __builtin_bit_cast(float, __builtin_amdgcn_readlane(__builtin_bit_cast(int, v), 16));
  const float c = __builtin_bit_cast(float, __builtin_amdgcn_readlane(__builtin_bit_cast(int, v), 32));
  const float d = __builtin_bit_cast(float, __builtin_amdgcn_readlane(__builtin_bit_cast(int, v), 48));
  return (a + b) + (c + d);
}

__device__ __forceinline__ f32x4 load_mod4(const Params& P, int b, int col) {
  return *(const f32x4*)((const float*)(P.ws + WS_MODP) + (size_t)b * 6144 + col);
}

__device__ __forceinline__ void phase_mod(const Params& P, int bid, int nb, float* lds) {
  if (bid >= 96) return;
  const int t = opaque_tid(), kq = t >> 6, cl = t & 63;
  float* sc = lds;
  float* red = lds + 8192;
  for (int i = t; i < 8192; i += 512) sc[i] = siluf(P.c[i]);
  __syncthreads();
  for (int cg = bid; cg < 96; cg += nb) {
    float acc[8];
#pragma unroll
    for (int b = 0; b < 8; ++b) acc[b] = 0.f;
    const float* wp = P.w_ada + (size_t)(kq * 128) * 6144 + cg * 64 + cl;
#pragma unroll 8
    for (int k = 0; k < 128; ++k) {
      const float w = wp[(size_t)k * 6144];
#pragma unroll
      for (int b = 0; b < 8; ++b) acc[b] += sc[b * 1024 + kq * 128 + k] * w;
    }
#pragma unroll
    for (int b = 0; b < 8; ++b) red[(kq * 8 + b) * 64 + cl] = acc[b];
    __syncthreads();
    {
      const int b = t >> 6, c2 = t & 63;
      float sum = P.b_ada[cg * 64 + c2];
#pragma unroll
      for (int q = 0; q < 8; ++q) sum += red[(q * 8 + b) * 64 + c2];
      ((float*)(P.ws + WS_MODP))[(size_t)b * 6144 + cg * 64 + c2] = sum;
    }
    __syncthreads();
  }
}

__device__ __forceinline__ void transpose_item(const float* W, int ldw, int K, bf16_t* WT, LAS float* scr, int k0, int n0d, int n0s, int lane) {
#pragma unroll 8
  for (int i = 0; i < 32; ++i) { const int kk = 2 * i + (lane >> 5); scr[kk * 33 + (lane & 31)] = W[(size_t)(k0 + kk) * ldw + n0s + (lane & 31)]; }
  asm volatile("s_waitcnt lgkmcnt(0)" ::: "memory");
  const int c = lane & 7;
#pragma unroll
  for (int j = 0; j < 4; ++j) { const int n = (lane >> 3) + 8 * j; const LAS float* sp = scr + (8 * c) * 33 + n;
    u32x4 o; o.x = pack2(sp[0 * 33], sp[1 * 33]); o.y = pack2(sp[2 * 33], sp[3 * 33]); o.z = pack2(sp[4 * 33], sp[5 * 33]); o.w = pack2(sp[6 * 33], sp[7 * 33]);
    *(u32x4*)(WT + (size_t)(n0d + n) * K + k0 + 8 * c) = o; }
  asm volatile("s_waitcnt lgkmcnt(0)" ::: "memory");
}
constexpr int CV_IN = 16 * 112, CV_OUT = 16 * 32, CV_FF1 = 16 * 128, CV_FF2 = 64 * 32, CV_ITEMS = CV_IN + CV_OUT + CV_FF1 + CV_FF2;
__device__ __forceinline__ void phase_convert(const Params& P, int gw, int ngw, LAS float* scr, int lane) {
  for (int it = gw; it < CV_ITEMS; it += ngw) {
    int r = it;
    if (r < CV_IN) { const int kb = r / 112, nb = r % 112, n0 = 32 * nb; transpose_item(P.w_in, DIN, D, (bf16_t*)(P.ws + WS_WT_IN), scr, 64 * kb, n0, n0 + (n0 >= 2048 ? 8 : 0), lane); continue; } r -= CV_IN;
    if (r < CV_OUT) { const int kb = r / 32, nb = r % 32; transpose_item(P.w_out, D, D, (bf16_t*)(P.ws + WS_WT_OUT), scr, 64 * kb, 32 * nb, 32 * nb, lane); continue; } r -= CV_OUT;
    if (r < CV_FF1) { const int kb = r / 128, nb = r % 128; transpose_item(P.w_ff1, DFF, D, (bf16_t*)(P.ws + WS_WT_FF1), scr, 64 * kb, 32 * nb, 32 * nb, lane); continue; } r -= CV_FF1;
    { const int kb = r / 32, nb = r % 32; transpose_item(P.w_ff2, D, DFF, (bf16_t*)(P.ws + WS_WT_FF2), scr, 64 * kb, 32 * nb, 32 * nb, lane); }
  }
}

__device__ __forceinline__ float reduce8(float (&pa)[8], int lane) {
  float q[4], r2[2];
#pragma unroll
  for (int i = 0; i < 4; ++i) { const float send = (lane & 32) ? pa[i] : pa[i + 4], keep = (lane & 32) ? pa[i + 4] : pa[i]; q[i] = keep + __shfl_xor(send, 32); }
#pragma unroll
  for (int i = 0; i < 2; ++i) { const float send = (lane & 16) ? q[i] : q[i + 2], keep = (lane & 16) ? q[i + 2] : q[i]; r2[i] = keep + __shfl_xor(send, 16); }
  const float send = (lane & 8) ? r2[0] : r2[1], keep = (lane & 8) ? r2[1] : r2[0];
  float v = keep + __shfl_xor(send, 8);
  v += __shfl_xor(v, 4); v += __shfl_xor(v, 2); v += __shfl_xor(v, 1);
  return v;
}
__device__ __forceinline__ void phase_prenorm(const Params& P, int bid, int nb, LAS unsigned char* lds) {
  const int t = opaque_tid(), wv = t >> 6, lane = t & 63;
  const int rpw = M / (nb * 8), row0 = (bid * 8 + wv) * rpw, b = row0 / SEQ;
  bf16_t* H = (bf16_t*)(P.ws + WS_H);
  float* G = (float*)(P.ws + WS_G);
  float* BETA = (float*)(P.ws + WS_BETA);
  LAS f32x4* wa = (LAS f32x4*)lds;
  LAS f32x4* wb = (LAS f32x4*)(lds + 16384);
  __syncthreads();
  for (int k = t; k < 1024; k += 512) {
    const int slot = (((k >> 8) * 4 + (k & 3)) * 64) + ((k & 255) >> 2);
    wa[slot] = *(const f32x4*)(P.w_in + (size_t)k * DIN + 2048);
    wb[slot] = *(const f32x4*)(P.w_in + (size_t)k * DIN + 2052);
  }
  f32x4 mulv[4], shv[4];
#pragma unroll
  for (int j = 0; j < 4; ++j) {
    const int col = 4 * lane + 256 * j;
    shv[j] = load_mod4(P, b, 0 * D + col);
    mulv[j] = *(const f32x4*)(P.pre_mix_w + col) * (load_mod4(P, b, 1 * D + col) + 1.0f);
  }
  const float alog = P.dn_a_log[(lane >> 3) & 3], dtb = P.dn_dt_bias[(lane >> 3) & 3];
  __syncthreads();
  for (int it = 0; it < rpw; it += 2) {
    f32x4 xv[2][4];
#pragma unroll
    for (int u = 0; u < 2; ++u)
#pragma unroll
      for (int j = 0; j < 4; ++j) xv[u][j] = *(const f32x4*)(P.x + (size_t)(row0 + it + u) * D + 4 * lane + 256 * j);
#pragma unroll
    for (int u = 0; u < 2; ++u) {
      const int row = row0 + it + u;
      float ss = 0.f;
#pragma unroll
      for (int j = 0; j < 4; ++j) ss += xv[u][j][0] * xv[u][j][0] + xv[u][j][1] * xv[u][j][1] + xv[u][j][2] * xv[u][j][2] + xv[u][j][3] * xv[u][j][3];
      const float rstd = rsqrtf(wave_sum(ss) * (1.0f / D) + EPS);
      float pa[8];
#pragma unroll
      for (int i = 0; i < 8; ++i) pa[i] = 0.f;
#pragma unroll
      for (int j = 0; j < 4; ++j) {
        const f32x4 hv = xv[u][j] * rstd * mulv[j] + shv[j];
        u32x2 pk; pk[0] = pack2(hv[0], hv[1]); pk[1] = pack2(hv[2], hv[3]);
        *(u32x2*)(H + (size_t)row * D + 4 * lane + 256 * j) = pk;
#pragma unroll
        for (int e = 0; e < 4; ++e) {
          const f32x4 a4 = wa[(j * 4 + e) * 64 + lane], b4 = wb[(j * 4 + e) * 64 + lane];
          pa[0] += hv[e] * a4[0]; pa[1] += hv[e] * a4[1]; pa[2] += hv[e] * a4[2]; pa[3] += hv[e] * a4[3];
          pa[4] += hv[e] * b4[0]; pa[5] += hv[e] * b4[1]; pa[6] += hv[e] * b4[2]; pa[7] += hv[e] * b4[3];
        }
      }
      const float v = reduce8(pa, lane);
      if ((lane & 7) == 0) {
        const int idx = lane >> 3;
        if (idx < 4) G[(size_t)row * 4 + idx] = -expf(alog) * softplusf_(v + dtb);
        else BETA[(size_t)row * 4 + (idx - 4)] = sigmoidf_(v);
      }
    }
  }
}

typedef short bf16x8 __attribute__((ext_vector_type(8)));
typedef float f32x16 __attribute__((ext_vector_type(16)));
#define MFMA32(a, b, c) __builtin_amdgcn_mfma_f32_32x32x16_bf16((a), (b), (c), 0, 0, 0)
__device__ __forceinline__ int crow(int reg, int hh) { return (reg & 3) + 8 * (reg >> 2) + 4 * hh; }
__device__ __forceinline__ int swap23(int k) { return (k & ~12) | ((k & 4) << 1) | ((k & 8) >> 1); }
template <int S_> __device__ __forceinline__ bf16x8 pack_step(const f32x16& x) {
  u32x4 p; p[0] = pack2(x[8 * S_ + 0], x[8 * S_ + 1]); p[1] = pack2(x[8 * S_ + 2], x[8 * S_ + 3]); p[2] = pack2(x[8 * S_ + 4], x[8 * S_ + 5]); p[3] = pack2(x[8 * S_ + 6], x[8 * S_ + 7]);
  return __builtin_bit_cast(bf16x8, p);
}
__device__ __forceinline__ f32x16 zero16() { f32x16 z;
#pragma unroll
  for (int i = 0; i < 16; ++i) z[i] = 0.f;
  return z; }

template <int I> __device__ __forceinline__ void solve_rows(const LAS float* Ab, int c, float (&T)[32], f32x4 (&rvF)[8], f32x4 (&rvA)[8], f32x4 (&rvB)[8]) {
  if constexpr (I + 2 < 32) {
    const LAS float* Ar = Ab;
    if constexpr (I >= 2) asm volatile("" : "+v"(Ar) : "v"(T[I - 1]));
#pragma unroll
    for (int q = 0; q < (I + 2 + 3) / 4; ++q) rvF[q] = *(const LAS f32x4*)(Ar + (I + 2) * 68 + 4 * q);
  }
  __builtin_amdgcn_sched_barrier(0);
  float acc = (c == I) ? 1.f : 0.f;
#pragma unroll
  for (int j = 0; j < I; ++j) acc -= rvA[j >> 2][j & 3] * T[j];
  T[I] = acc;
  __builtin_amdgcn_sched_barrier(0);
  if constexpr (I + 1 < 32) solve_rows<I + 1>(Ab, c, T, rvA, rvB, rvF);
}

constexpr int PA_QS = 0, PA_KS = 17408, PA_KT = 34816, PA_VT = 53248, PA_AM = 71680, PA_T1 = 89088, PA_T2 = 98304, PA_GC = 107520, PA_BETA = 107776, PA_TL = 108032, PA_KDS = 117248;
constexpr float QSCALE = 0.08838834764831845f;
#define PREP_BAR() do { asm volatile("s_waitcnt lgkmcnt(0)" ::: "memory"); __builtin_amdgcn_s_barrier(); asm volatile("" ::: "memory"); } while (0)
__device__ __forceinline__ void phase_chunk_prep(const Params& P, int ci, LAS unsigned char* lds) {
  const int bh = ci >> 5, n = ci & 31, b = bh >> 2, h = bh & 3;
  const int t = opaque_tid(), w = __builtin_amdgcn_readfirstlane(t >> 6);
  int lane = t & 63, r = lane & 31, hh = lane >> 5;
#define OPAQUE_LANE() do { asm volatile("" : "+v"(lane)); r = lane & 31; hh = lane >> 5; } while (0)
  const bf16_t* PROJ = (const bf16_t*)(P.ws + WS_PROJ);
  const size_t row0 = (size_t)b * SEQ + n * 64;
  LAS float* gcs = (LAS float*)(lds + PA_GC);
  LAS float* betas = (LAS float*)(lds + PA_BETA);
  LAS float* Am = (LAS float*)(lds + PA_AM);
  PREP_BAR();
  float gc = ((const float*)(P.ws + WS_G))[(row0 + lane) * 4 + h];
  const float betal = ((const float*)(P.ws + WS_BETA))[(row0 + lane) * 4 + h];
#pragma unroll
  for (int o = 1; o < 64; o <<= 1) { const float v = __shfl_up(gc, o); if (lane >= o) gc += v; }
  const float glast = __shfl(gc, 63);
  if (w == 0) { gcs[lane] = gc; betas[lane] = betal; if (lane == 63) ((float*)(P.ws + WS_GL))[ci] = __expf(gc); }
  OPAQUE_LANE();
  {
    const int t0 = 8 * w, colb = h * HD + 2 * lane;
    float cw[4][3][2];
#pragma unroll
    for (int j = 0; j < 4; ++j)
#pragma unroll
      for (int p = 0; p < 3; ++p) { const f32x2 v2 = *(const f32x2*)(P.dn_conv_w + j * 1536 + p * 512 + colb); cw[j][p][0] = v2[0]; cw[j][p][1] = v2[1]; }
    unsigned raw[11][3];
#pragma unroll
    for (int rr = 0; rr < 11; ++rr) {
      const int tk = n * 64 + t0 - 3 + rr;
#pragma unroll
      for (int p = 0; p < 3; ++p) raw[rr][p] = tk >= 0 ? *(const unsigned*)(PROJ + ((size_t)b * SEQ + tk) * DP + p * 512 + colb) : 0u;
    }
    float rf[11][3][2];
#pragma unroll
    for (int rr = 0; rr < 11; ++rr)
#pragma unroll
      for (int p = 0; p < 3; ++p) { rf[rr][p][0] = bflo(raw[rr][p]); rf[rr][p][1] = bfhi(raw[rr][p]); }
    bf16_t* QG = (bf16_t*)(P.ws + WS_QG);
#pragma unroll
    for (int tt = 0; tt < 8; ++tt) {
      float c[3][2];
#pragma unroll
      for (int p = 0; p < 3; ++p) {
        float a0 = 0.f, a1 = 0.f;
#pragma unroll
        for (int j = 0; j < 4; ++j) { a0 += cw[j][p][0] * rf[tt + j][p][0]; a1 += cw[j][p][1] * rf[tt + j][p][1]; }
        c[p][0] = siluf(a0); c[p][1] = siluf(a1);
      }
      const float rq = rsqrtf(wave_sum(c[0][0] * c[0][0] + c[0][1] * c[0][1]) + EPS) * QSCALE;
      const float rk = rsqrtf(wave_sum(c[1][0] * c[1][0] + c[1][1] * c[1][1]) + EPS);
      const float q0 = c[0][0] * rq, q1 = c[0][1] * rq, k0 = c[1][0] * rk, k1 = c[1][1] * rk;
      const int tok = t0 + tt;
      const float gct = __shfl(gc, tok);
      const float egc = __expf(gct), ekd = __expf(glast - gct);
      *(LAS unsigned*)(lds + PA_QS + tok * 272 + 4 * lane) = pack2(q0, q1);
      const unsigned kp = pack2(k0, k1), vp = pack2(c[2][0], c[2][1]), dp = pack2(k0 * ekd, k1 * ekd);
      *(LAS unsigned*)(lds + PA_KS + tok * 272 + 4 * lane) = kp;
      *(unsigned*)(QG + ((size_t)ci * 64 + tok) * 128 + swap23(2 * lane)) = pack2(q0 * egc, q1 * egc);
      *(LAS bf16_t*)(lds + PA_KT + (2 * lane) * 144 + tok * 2) = (bf16_t)(kp & 0xffffu);
      *(LAS bf16_t*)(lds + PA_KT + (2 * lane + 1) * 144 + tok * 2) = (bf16_t)(kp >> 16);
      *(LAS bf16_t*)(lds + PA_VT + (2 * lane) * 144 + tok * 2) = (bf16_t)(vp & 0xffffu);
      *(LAS bf16_t*)(lds + PA_VT + (2 * lane + 1) * 144 + tok * 2) = (bf16_t)(vp >> 16);
      *(LAS bf16_t*)(lds + PA_KDS + (2 * lane) * 144 + tok * 2) = (bf16_t)(dp & 0xffffu);
      *(LAS bf16_t*)(lds + PA_KDS + (2 * lane + 1) * 144 + tok * 2) = (bf16_t)(dp >> 16);
    }
  }
  PREP_BAR();
  OPAQUE_LANE();
  if (w < 3) {
    const int ti = (w >= 1) ? 1 : 0, tj = (w == 2) ? 1 : 0;
    f32x16 acc = zero16();
#pragma unroll
    for (int ks = 0; ks < 8; ++ks) {
      const bf16x8 a = *(const LAS bf16x8*)(lds + PA_KS + (32 * ti + r) * 272 + (16 * ks + 8 * hh) * 2);
      const bf16x8 bb = *(const LAS bf16x8*)(lds + PA_KS + (32 * tj + r) * 272 + (16 * ks + 8 * hh) * 2);
      acc = MFMA32(a, bb, acc);
    }
    const int j = 32 * tj + r; const float gcj = gcs[j];
#pragma unroll
    for (int reg = 0; reg < 16; ++reg) {
      const int i = 32 * ti + crow(reg, hh);
      const float dec = __expf(fminf(gcs[i] - gcj, 0.f));
      Am[i * 68 + j] = (i > j) ? betas[i] * acc[reg] * dec : 0.f;
    }
  } else if (w < 7) {
    const int idx = w - 3, tj = (idx >= 2) ? 1 : 0, ti = (idx == 1 || idx == 2) ? 1 : 0;
    f32x16 acc = zero16();
    if (!(tj == 1 && ti == 0)) {
#pragma unroll
      for (int ks = 0; ks < 8; ++ks) {
        const bf16x8 a = *(const LAS bf16x8*)(lds + PA_KS + (32 * tj + r) * 272 + (16 * ks + 8 * hh) * 2);
        const bf16x8 bb = *(const LAS bf16x8*)(lds + PA_QS + (32 * ti + r) * 272 + (16 * ks + 8 * hh) * 2);
        acc = MFMA32(a, bb, acc);
      }
    }
    const int i = 32 * ti + r; const float gci = gcs[i];
    f32x16 x;
#pragma unroll
    for (int reg = 0; reg < 16; ++reg) {
      const int j = 32 * tj + crow(reg, hh);
      const float dec = __expf(fminf(gci - gcs[j], 0.f));
      x[reg] = (i >= j) ? acc[reg] * dec : 0.f;
    }
    bf16_t* ATT = (bf16_t*)(P.ws + WS_ATT) + ((size_t)ci * 64 + i) * 64 + 32 * tj + 8 * hh;
    *(bf16x8*)(ATT) = pack_step<0>(x);
    *(bf16x8*)(ATT + 16) = pack_step<1>(x);
  } else {
    bf16_t* KD = (bf16_t*)(P.ws + WS_KD) + (size_t)ci * 128 * 64;
#pragma unroll 4
    for (int it = 0; it < 16; ++it) {
      const int idx = it * 64 + lane, dk = idx >> 3, pp = idx & 7;
      const u32x2 lo = *(const LAS u32x2*)(lds + PA_KDS + dk * 144 + swap23(8 * pp) * 2);
      const u32x2 hi = *(const LAS u32x2*)(lds + PA_KDS + dk * 144 + swap23(8 * pp + 4) * 2);
      u32x4 o; o[0] = lo[0]; o[1] = lo[1]; o[2] = hi[0]; o[3] = hi[1];
      *(u32x4*)(KD + dk * 64 + 8 * pp) = o;
    }
  }
  PREP_BAR();
  OPAQUE_LANE();
  if (w < 2) {
    const int d = w, c = r;
    LAS float* TL = (LAS float*)(lds + PA_TL);
    const LAS float* Ab = Am + (32 * d) * 68 + 32 * d;
    float T[32];
    f32x4 rv0[8], rv1[8], rv2[8];
    T[0] = (c == 0) ? 1.f : 0.f;
    rv1[0] = *(const LAS f32x4*)(Ab + 1 * 68); rv2[0] = *(const LAS f32x4*)(Ab + 2 * 68);
    solve_rows<1>(Ab, c, T, rv0, rv1, rv2);
    const float bc = betas[32 * d + c], bg = -bc * __expf(gcs[32 * d + c]);
    if (hh == 0) {
#pragma unroll
      for (int i = 0; i < 32; ++i) {
        TL[(32 * d + i) * 36 + c] = T[i];
        *(LAS bf16_t*)(lds + PA_T1 + (32 * d + i) * 144 + 2 * (32 * d + c)) = (bf16_t)(pack2(T[i] * bc, 0.f) & 0xffffu);
        *(LAS bf16_t*)(lds + PA_T2 + (32 * d + i) * 144 + 2 * (32 * d + c)) = (bf16_t)(pack2(T[i] * bg, 0.f) & 0xffffu);
      }
    }
  }
  PREP_BAR();
  OPAQUE_LANE();
  if (w == 0) {
    const LAS float* TL = (const LAS float*)(lds + PA_TL);
    f32x16 X = zero16(), Y = zero16();
#pragma unroll
    for (int ks = 0; ks < 16; ++ks) X = __builtin_amdgcn_mfma_f32_32x32x2f32(Am[(32 + r) * 68 + 2 * ks + hh], TL[(2 * ks + hh) * 36 + r], X, 0, 0, 0);
#pragma unroll
    for (int s2 = 0; s2 < 16; ++s2) Y = __builtin_amdgcn_mfma_f32_32x32x2f32(TL[(32 + r) * 36 + crow(s2, hh)], X[s2], Y, 0, 0, 0);
    const float bc = betas[r], bg = -bc * __expf(gcs[r]);
#pragma unroll
    for (int reg = 0; reg < 16; ++reg) {
      const int i = crow(reg, hh);
      *(LAS bf16_t*)(lds + PA_T1 + (32 + i) * 144 + 2 * r) = (bf16_t)(pack2(-Y[reg] * bc, 0.f) & 0xffffu);
      *(LAS bf16_t*)(lds + PA_T2 + (32 + i) * 144 + 2 * r) = (bf16_t)(pack2(-Y[reg] * bg, 0.f) & 0xffffu);
      *(LAS bf16_t*)(lds + PA_T1 + i * 144 + 2 * (32 + r)) = (bf16_t)0;
      *(LAS bf16_t*)(lds + PA_T2 + i * 144 + 2 * (32 + r)) = (bf16_t)0;
    }
  }
  PREP_BAR();
  OPAQUE_LANE();
  {
    const int mt = w >> 2, nt = w & 3;
    f32x16 acc = zero16();
#pragma unroll
    for (int ks = 0; ks < 4; ++ks) {
      const bf16x8 a = *(const LAS bf16x8*)(lds + PA_T1 + (32 * mt + r) * 144 + (16 * ks + 8 * hh) * 2);
      const bf16x8 bb = *(const LAS bf16x8*)(lds + PA_VT + (32 * nt + r) * 144 + (16 * ks + 8 * hh) * 2);
      acc = MFMA32(a, bb, acc);
    }
    float* U = (float*)(P.ws + WS_U) + ((((size_t)ci * 4 + nt) * 2 + mt) * 4) * 256 + lane * 4;
#pragma unroll
    for (int q = 0; q < 4; ++q) { f32x4 v4 = {acc[4 * q], acc[4 * q + 1], acc[4 * q + 2], acc[4 * q + 3]}; *(f32x4*)(U + q * 256) = v4; }
    const int dt = w >> 1, it = w & 1;
    f32x16 acc2 = zero16();
#pragma unroll
    for (int ks = 0; ks < 4; ++ks) {
      const bf16x8 a = *(const LAS bf16x8*)(lds + PA_KT + (32 * dt + r) * 144 + (16 * ks + 8 * hh) * 2);
      const bf16x8 bb = *(const LAS bf16x8*)(lds + PA_T2 + (32 * it + r) * 144 + (16 * ks + 8 * hh) * 2);
      acc2 = MFMA32(a, bb, acc2);
    }
    bf16_t* WN = (bf16_t*)(P.ws + WS_WN) + ((size_t)ci * 64 + 32 * it + r) * 128 + 32 * dt + 8 * hh;
    *(bf16x8*)(WN) = pack_step<0>(acc2);
    *(bf16x8*)(WN + 16) = pack_step<1>(acc2);
  }
}

constexpr int SC_WN = 0, SC_QG = 17408, SC_KD = 34816, SC_ATT = 53248, SC_U = 62464, SC_SLOT = 70656;
template <int K_> __device__ __forceinline__ void scan_piece(int lt, int ci, int dvs, const unsigned char* ws, const unsigned char*& src, int& dst) {
  if (K_ < 4) { const int q = K_ * 256 + lt; src = ws + WS_WN + (size_t)ci * 16384 + q * 16; dst = SC_WN + (q >> 4) * 272 + (q & 15) * 16; }
  else if (K_ < 8) { const int q = (K_ - 4) * 256 + lt; src = ws + WS_QG + (size_t)ci * 16384 + q * 16; dst = SC_QG + (q >> 4) * 272 + (q & 15) * 16; }
  else if (K_ < 12) { const int q = (K_ - 8) * 256 + lt; src = ws + WS_KD + (size_t)ci * 16384 + q * 16; dst = SC_KD + (q >> 3) * 144 + (q & 7) * 16; }
  else if (K_ < 14) { const int q = (K_ - 12) * 256 + lt; src = ws + WS_ATT + (size_t)ci * 8192 + q * 16; dst = SC_ATT + (q >> 3) * 144 + (q & 7) * 16; }
  else { const int q = (K_ - 14) * 256 + lt; src = ws + WS_U + ((size_t)ci * 4 + dvs) * 8192 + q * 16; dst = SC_U + q * 16; }
}
template <int K_> __device__ __forceinline__ void scan_load(u32x4 (&R)[16], int lt, int ci, int dvs, const unsigned char* ws) {
  const unsigned char* src; int dst; scan_piece<K_>(lt, ci, dvs, ws, src, dst); R[K_] = *(const u32x4*)src;
  if constexpr (K_ + 1 < 16) scan_load<K_ + 1>(R, lt, ci, dvs, ws);
}
template <int K_> __device__ __forceinline__ void scan_store(const u32x4 (&R)[16], int lt, int dvs, const unsigned char* ws, LAS unsigned char* slot) {
  const unsigned char* src; int dst; scan_piece<K_>(lt, 0, dvs, ws, src, dst); *(LAS u32x4*)(slot + dst) = R[K_];
  if constexpr (K_ + 1 < 16) scan_store<K_ + 1>(R, lt, dvs, ws, slot);
}
#define SCAN_BAR() do { asm volatile("s_waitcnt lgkmcnt(0)" ::: "memory"); __builtin_amdgcn_s_barrier(); asm volatile("" ::: "memory"); } while (0)
__device__ __forceinline__ void phase_scan(const Params& P, int item, LAS unsigned char* lds) {
  const int bh = item >> 2, dvs = item & 3, b = bh >> 2, h = bh & 3;
  const int t = opaque_tid(), w = __builtin_amdgcn_readfirstlane(t >> 6), lane = t & 63, r = lane & 31, hh = lane >> 5;
  const int ci0 = bh * 32, ltid = t - 64;
  const unsigned char* ws = P.ws;
  __syncthreads();
  if (w > 0) {
    if (w <= 4) {
      const int lt = t - 64;
      u32x4 R[16];
      scan_load<0>(R, lt, ci0, dvs, ws);
      scan_store<0>(R, lt, dvs, ws, lds);
      scan_load<0>(R, lt, ci0 + 1, dvs, ws);
      SCAN_BAR();
      for (int n = 0; n < 32; ++n) {
        if (n + 1 < 32) scan_store<0>(R, lt, dvs, ws, lds + ((n + 1) & 1) * SC_SLOT);
        if (n + 2 < 32) scan_load<0>(R, lt, ci0 + n + 2, dvs, ws);
        SCAN_BAR();
      }
    } else {
      SCAN_BAR();
      for (int n = 0; n < 32; ++n) SCAN_BAR();
    }
  } else {
    f32x16 S[4];
#pragma unroll
    for (int kt = 0; kt < 4; ++kt) S[kt] = zero16();
    const float egl_all = ((const float*)(ws + WS_GL))[ci0 + (lane & 31)];
    SCAN_BAR();
    for (int n = 0; n < 32; ++n) {
      const LAS unsigned char* sl = lds + (n & 1) * SC_SLOT;
      const float egl = __builtin_bit_cast(float, __builtin_amdgcn_readlane(__builtin_bit_cast(int, egl_all), n));
      const LAS unsigned char* pw = sl + SC_WN + r * 272 + hh * 16;
      const LAS unsigned char* pq = sl + SC_QG + r * 272 + hh * 16;
      const LAS unsigned char* pa = sl + SC_ATT + r * 144 + hh * 16;
      const LAS unsigned char* pk = sl + SC_KD + r * 144 + hh * 16;
      bf16x8 FA[8], FB[8];
#pragma unroll
      for (int ks = 0; ks < 8; ++ks) FA[ks] = *(const LAS bf16x8*)(pw + ks * 32);
      f32x16 av[2], ao[2];
#pragma unroll
      for (int mt = 0; mt < 2; ++mt) {
#pragma unroll
        for (int q = 0; q < 4; ++q) { const f32x4 uq = *(const LAS f32x4*)(sl + SC_U + ((mt * 4 + q) * 64 + lane) * 16); av[mt][4 * q] = uq[0]; av[mt][4 * q + 1] = uq[1]; av[mt][4 * q + 2] = uq[2]; av[mt][4 * q + 3] = uq[3]; }
        ao[mt] = zero16();
      }
      bf16x8 Sb[8];
      Sb[0] = pack_step<0>(S[0]); Sb[1] = pack_step<1>(S[0]); Sb[2] = pack_step<0>(S[1]); Sb[3] = pack_step<1>(S[1]);
      Sb[4] = pack_step<0>(S[2]); Sb[5] = pack_step<1>(S[2]); Sb[6] = pack_step<0>(S[3]); Sb[7] = pack_step<1>(S[3]);
      __builtin_amdgcn_sched_barrier(0);
#pragma unroll
      for (int ks = 0; ks < 8; ++ks) FB[ks] = *(const LAS bf16x8*)(pw + 8704 + ks * 32);
#pragma unroll
      for (int ks = 0; ks < 8; ++ks) av[0] = MFMA32(FA[ks], Sb[ks], av[0]);
      __builtin_amdgcn_sched_barrier(0);
#pragma unroll
      for (int ks = 0; ks < 8; ++ks) FA[ks] = *(const LAS bf16x8*)(pq + ks * 32);
#pragma unroll
      for (int ks = 0; ks < 8; ++ks) av[1] = MFMA32(FB[ks], Sb[ks], av[1]);
      __builtin_amdgcn_sched_barrier(0);
#pragma unroll
      for (int ks = 0; ks < 8; ++ks) FB[ks] = *(const LAS bf16x8*)(pq + 8704 + ks * 32);
#pragma unroll
      for (int ks = 0; ks < 8; ++ks) ao[0] = MFMA32(FA[ks], Sb[ks], ao[0]);
      __builtin_amdgcn_sched_barrier(0);
#pragma unroll
      for (int ks = 0; ks < 4; ++ks) { FA[ks] = *(const LAS bf16x8*)(pa + ks * 32); FA[4 + ks] = *(const LAS bf16x8*)(pa + 4608 + ks * 32); }
#pragma unroll
      for (int ks = 0; ks < 8; ++ks) ao[1] = MFMA32(FB[ks], Sb[ks], ao[1]);
      bf16x8 Vb[4];
      Vb[0] = pack_step<0>(av[0]); Vb[1] = pack_step<1>(av[0]); Vb[2] = pack_step<0>(av[1]); Vb[3] = pack_step<1>(av[1]);
#pragma unroll
      for (int kt = 0; kt < 4; ++kt) S[kt] = S[kt] * egl;
      __builtin_amdgcn_sched_barrier(0);
#pragma unroll
      for (int ks = 0; ks < 4; ++ks) { FB[ks] = *(const LAS bf16x8*)(pk + ks * 32); FB[4 + ks] = *(const LAS bf16x8*)(pk + 4608 + ks * 32); }
#pragma unroll
      for (int ks = 0; ks < 4; ++ks) { ao[0] = MFMA32(FA[ks], Vb[ks], ao[0]); ao[1] = MFMA32(FA[4 + ks], Vb[ks], ao[1]); }
      __builtin_amdgcn_sched_barrier(0);
#pragma unroll
      for (int ks = 0; ks < 4; ++ks) { FA[ks] = *(const LAS bf16x8*)(pk + 2 * 4608 + ks * 32); FA[4 + ks] = *(const LAS bf16x8*)(pk + 3 * 4608 + ks * 32); }
#pragma unroll
      for (int ks = 0; ks < 4; ++ks) { S[0] = MFMA32(FB[ks], Vb[ks], S[0]); S[1] = MFMA32(FB[4 + ks], Vb[ks], S[1]); }
      __builtin_amdgcn_sched_barrier(0);
#pragma unroll
      for (int ks = 0; ks < 4; ++ks) { S[2] = MFMA32(FA[ks], Vb[ks], S[2]); S[3] = MFMA32(FA[4 + ks], Vb[ks], S[3]); }
      bf16_t* O = (bf16_t*)(P.ws + WS_O) + ((size_t)b * SEQ + n * 64) * 512 + h * HD + 32 * dvs + r;
#pragma unroll
      for (int mt = 0; mt < 2; ++mt)
#pragma unroll
        for (int reg = 0; reg < 16; ++reg) O[(size_t)(32 * mt + crow(reg, hh)) * 512] = (bf16_t)(pack2(ao[mt][reg], 0.f) & 0xffffu);
      SCAN_BAR();
    }
  }
  __syncthreads();
}

__device__ __forceinline__ void unpack8(const u32x4& v, float (&f)[8]) {
#pragma unroll
  for (int i = 0; i < 4; ++i) { f[2 * i] = bflo(v[i]); f[2 * i + 1] = bfhi(v[i]); }
}
__device__ __forceinline__ void phase_gate_mix(const Params& P, int bid, int nb) {
  const int t = opaque_tid(), wv = t >> 6, lane = t & 63;
  const int rpw = M / (nb * 8), row0 = (bid * 8 + wv) * rpw;
  const bf16_t* PROJ = (const bf16_t*)(P.ws + WS_PROJ);
  const bf16_t* O = (const bf16_t*)(P.ws + WS_O);
  bf16_t* MIX = (bf16_t*)(P.ws + WS_MIX);
  const int col = 8 * lane;
  float nw[8], cw[3][8];
  { const f32x4 n0 = *(const f32x4*)(P.dn_norm_w + (col & 127)), n1 = *(const f32x4*)(P.dn_norm_w + (col & 127) + 4);
#pragma unroll
    for (int i = 0; i < 4; ++i) { nw[i] = n0[i]; nw[4 + i] = n1[i]; } }
#pragma unroll
  for (int j = 0; j < 3; ++j) { const f32x4 c0 = *(const f32x4*)(P.sc_conv_w + j * 512 + col), c1 = *(const f32x4*)(P.sc_conv_w + j * 512 + col + 4);
#pragma unroll
    for (int i = 0; i < 4; ++i) { cw[j][i] = c0[i]; cw[j][4 + i] = c1[i]; } }
  float pm2[8], pm1[8];
  {
    const int tk0 = row0 % SEQ;
    float cf[8], hf[8];
    if (tk0 >= 2) { unpack8(*(const u32x4*)(PROJ + (size_t)(row0 - 2) * DP + OFF_SC + col), cf); unpack8(*(const u32x4*)(PROJ + (size_t)(row0 - 2) * DP + OFF_SH + col), hf);
#pragma unroll
      for (int i = 0; i < 8; ++i) pm2[i] = cf[i] * hf[i]; }
    else {
#pragma unroll
      for (int i = 0; i < 8; ++i) pm2[i] = 0.f; }
    if (tk0 >= 1) { unpack8(*(const u32x4*)(PROJ + (size_t)(row0 - 1) * DP + OFF_SC + col), cf); unpack8(*(const u32x4*)(PROJ + (size_t)(row0 - 1) * DP + OFF_SH + col), hf);
#pragma unroll
      for (int i = 0; i < 8; ++i) pm1[i] = cf[i] * hf[i]; }
    else {
#pragma unroll
      for (int i = 0; i < 8; ++i) pm1[i] = 0.f; }
  }
  for (int it = 0; it < rpw; it += 2) {
    u32x4 ov[2], zv[2], bv[2], cv[2], hv[2];
#pragma unroll
    for (int u = 0; u < 2; ++u) {
      const size_t row = row0 + it + u;
      ov[u] = *(const u32x4*)(O + row * 512 + col);
      zv[u] = *(const u32x4*)(PROJ + row * DP + OFF_Z + col);
      bv[u] = *(const u32x4*)(PROJ + row * DP + OFF_SB + col);
      cv[u] = *(const u32x4*)(PROJ + row * DP + OFF_SC + col);
      hv[u] = *(const u32x4*)(PROJ + row * DP + OFF_SH + col);
    }
#pragma unroll
    for (int u = 0; u < 2; ++u) {
      const size_t row = row0 + it + u;
      float o[8], z[8], sb[8], sc[8], sh[8];
      unpack8(ov[u], o); unpack8(zv[u], z); unpack8(bv[u], sb); unpack8(cv[u], sc); unpack8(hv[u], sh);
      float ss = 0.f;
#pragma unroll
      for (int i = 0; i < 8; ++i) ss += o[i] * o[i];
      ss = row16_sum(ss);
      const float rstd = rsqrtf(ss * (1.0f / HD) + EPS);
      u32x4 r1, r2;
#pragma unroll
      for (int i = 0; i < 4; ++i) r1[i] = pack2(o[2 * i] * rstd * nw[2 * i] * siluf(z[2 * i]), o[2 * i + 1] * rstd * nw[2 * i + 1] * siluf(z[2 * i + 1]));
      *(u32x4*)(MIX + row * D + col) = r1;
      float y[8];
#pragma unroll
      for (int i = 0; i < 8; ++i) { const float p0 = sc[i] * sh[i]; y[i] = sb[i] * (cw[0][i] * pm2[i] + cw[1][i] * pm1[i] + cw[2][i] * p0); pm2[i] = pm1[i]; pm1[i] = p0; }
#pragma unroll
      for (int i = 0; i < 4; ++i) r2[i] = pack2(y[2 * i], y[2 * i + 1]);
      *(u32x4*)(MIX + row * D + 512 + col) = r2;
    }
  }
}

__device__ __forceinline__ void phase_post1(const Params& P, int bid, int nb) {
  const int t = opaque_tid(), wv = t >> 6, lane = t & 63;
  const int rpw = M / (nb * 8), row0 = (bid * 8 + wv) * rpw, b = row0 / SEQ;
  const bf16_t* Y = (const bf16_t*)(P.ws + WS_Y);
  bf16_t* H2 = (bf16_t*)(P.ws + WS_H2);
  f32x4 m1[4], m2[4], shf[4];
#pragma unroll
  for (int j = 0; j < 4; ++j) {
    const int col = 4 * lane + 256 * j;
    m1[j] = load_mod4(P, b, 2 * D + col) * *(const f32x4*)(P.post_mix_w + col);
    m2[j] = *(const f32x4*)(P.pre_ffn_w + col) * (load_mod4(P, b, 4 * D + col) + 1.0f);
    shf[j] = load_mod4(P, b, 3 * D + col);
  }
  for (int it = 0; it < rpw; it += 2) {
    f32x4 xv[2][4]; u32x2 yr[2][4];
#pragma unroll
    for (int u = 0; u < 2; ++u)
#pragma unroll
      for (int j = 0; j < 4; ++j) { xv[u][j] = *(const f32x4*)(P.x + (size_t)(row0 + it + u) * D + 4 * lane + 256 * j); yr[u][j] = *(const u32x2*)(Y + (size_t)(row0 + it + u) * D + 4 * lane + 256 * j); }
#pragma unroll
    for (int u = 0; u < 2; ++u) {
      const size_t row = row0 + it + u;
      f32x4 yv[4]; float ss = 0.f;
#pragma unroll
      for (int j = 0; j < 4; ++j) { yv[j][0] = bflo(yr[u][j][0]); yv[j][1] = bfhi(yr[u][j][0]); yv[j][2] = bflo(yr[u][j][1]); yv[j][3] = bfhi(yr[u][j][1]);
        ss += yv[j][0] * yv[j][0] + yv[j][1] * yv[j][1] + yv[j][2] * yv[j][2] + yv[j][3] * yv[j][3]; }
      const float rstd = rsqrtf(wave_sum(ss) * (1.0f / D) + EPS);
      f32x4 x1[4]; float ss2 = 0.f;
#pragma unroll
      for (int j = 0; j < 4; ++j) { x1[j] = xv[u][j] + yv[j] * rstd * m1[j]; *(f32x4*)(P.out + row * D + 4 * lane + 256 * j) = x1[j];
        ss2 += x1[j][0] * x1[j][0] + x1[j][1] * x1[j][1] + x1[j][2] * x1[j][2] + x1[j][3] * x1[j][3]; }
      const float rstd2 = rsqrtf(wave_sum(ss2) * (1.0f / D) + EPS);
#pragma unroll
      for (int j = 0; j < 4; ++j) { const f32x4 hv = x1[j] * rstd2 * m2[j] + shf[j]; u32x2 pk; pk[0] = pack2(hv[0], hv[1]); pk[1] = pack2(hv[2], hv[3]);
        *(u32x2*)(H2 + row * D + 4 * lane + 256 * j) = pk; }
    }
  }
}

__device__ __forceinline__ void phase_final(const Params& P, int bid, int nb) {
  const int t = opaque_tid(), wv = t >> 6, lane = t & 63;
  const int rpw = M / (nb * 8), row0 = (bid * 8 + wv) * rpw, b = row0 / SEQ;
  const bf16_t* Y2 = (const bf16_t*)(P.ws + WS_Y2);
  f32x4 m1[4];
#pragma unroll
  for (int j = 0; j < 4; ++j) { const int col = 4 * lane + 256 * j; m1[j] = load_mod4(P, b, 5 * D + col) * *(const f32x4*)(P.post_ffn_w + col); }
  for (int it = 0; it < rpw; it += 2) {
    f32x4 xv[2][4]; u32x2 yr[2][4];
#pragma unroll
    for (int u = 0; u < 2; ++u)
#pragma unroll
      for (int j = 0; j < 4; ++j) { xv[u][j] = *(const f32x4*)(P.out + (size_t)(row0 + it + u) * D + 4 * lane + 256 * j); yr[u][j] = *(const u32x2*)(Y2 + (size_t)(row0 + it + u) * D + 4 * lane + 256 * j); }
#pragma unroll
    for (int u = 0; u < 2; ++u) {
      const size_t row = row0 + it + u;
      f32x4 yv[4]; float ss = 0.f;
#pragma unroll
      for (int j = 0; j < 4; ++j) { yv[j][0] = bflo(yr[u][j][0]); yv[j][1] = bfhi(yr[u][j][0]); yv[j][2] = bflo(yr[u][j][1]); yv[j][3] = bfhi(yr[u][j][1]);
        ss += yv[j][0] * yv[j][0] + yv[j][1] * yv[j][1] + yv[j][2] * yv[j][2] + yv[j][3] * yv[j][3]; }
      const float rstd = rsqrtf(wave_sum(ss) * (1.0f / D) + EPS);
#pragma unroll
      for (int j = 0; j < 4; ++j) *(f32x4*)(P.out + row * D + 4 * lane + 256 * j) = xv[u][j] + yv[j] * rstd * m1[j];
    }
  }
}

#define XB_TMO      128
#define XB_XCNT(j)  (256  + 64 * (j))
#define XB_XSUB(j)  (1280 + 64 * (j))
#define XB_XGEN(j)  (2304 + 64 * (j))
#define XB_TOP      3328
#define XB_TOPGEN   3392
#define XCD_BAR_WORDS 3456
#define XB_SPIN_CAP (1u << 18)

__device__ __forceinline__ unsigned xb_ld(unsigned* p)              { return __hip_atomic_load(p, __ATOMIC_RELAXED, __HIP_MEMORY_SCOPE_AGENT); }
__device__ __forceinline__ unsigned xb_add(unsigned* p, unsigned v) { return __hip_atomic_fetch_add(p, v, __ATOMIC_RELAXED, __HIP_MEMORY_SCOPE_AGENT); }
__device__ __forceinline__ unsigned xb_xcc_id() { return (unsigned)__builtin_amdgcn_s_getreg((3 << 11) | 20) & 0xFu; }
#define XB_SPIN(cond, bar) do { unsigned _sp = 0; while (cond) { __builtin_amdgcn_s_sleep(1); \
    if ((++_sp & 255u) == 0u) { if (xb_ld(&(bar)[XB_TMO])) break; if (_sp > XB_SPIN_CAP) { atomicAdd(&(bar)[XB_TMO], 1u); break; } } } } while (0)

struct XcdBarrier {
    unsigned* bar; unsigned x;
    volatile LAS unsigned* st;
};

__device__ __forceinline__ XcdBarrier xcd_barrier_post(unsigned* bar, volatile LAS unsigned* st) {
    XcdBarrier b; b.bar = bar; b.x = xb_xcc_id(); b.st = st;
    if (threadIdx.x == 0) (void)xb_add(&bar[XB_XCNT(b.x)], 1u);
    return b;
}
__device__ __forceinline__ void xcd_barrier_complete(unsigned* bar, unsigned x, unsigned& nloc, unsigned& nx) {
    const unsigned G = gridDim.x * gridDim.y * gridDim.z;
    unsigned sum, cnt, mine, sp = 0u;
    for (;;) {
        sum = 0u; cnt = 0u; mine = 0u;
#pragma unroll
        for (unsigned j = 0; j < 16; ++j) { const unsigned c = xb_ld(&bar[XB_XCNT(j)]); sum += c; cnt += (c > 0u) ? 1u : 0u; mine = (j == x) ? c : mine; }
        if (sum == G) break;
        __builtin_amdgcn_s_sleep(1);
        if ((++sp & 255u) == 0u) { if (xb_ld(&bar[XB_TMO])) break; if (sp > XB_SPIN_CAP) { atomicAdd(&bar[XB_TMO], 1u); break; } }
    }
    nloc = mine > 0u ? mine : 1u; nx = cnt > 0u ? cnt : 1u;
}

__device__ __forceinline__ void xcd_barrier(const XcdBarrier& b) {
    asm volatile("s_waitcnt vmcnt(0)" ::: "memory");
    __syncthreads();
    if (threadIdx.x == 0) {
        unsigned* bar = b.bar;
        __builtin_amdgcn_s_waitcnt(0);
        unsigned nloc = b.st[0], nx = b.st[1];
        if (nloc == 0u) { xcd_barrier_complete(bar, b.x, nloc, nx); b.st[0] = nloc; b.st[1] = nx; }
        const unsigned old = xb_add(&bar[XB_XSUB(b.x)], 1u);
        const unsigned gen = old / nloc;
        if (old + 1u == (gen + 1u) * nloc) {
            __builtin_amdgcn_fence(__ATOMIC_RELEASE, "agent");
            asm volatile("s_waitcnt vmcnt(0)" ::: "memory");
            const unsigned og = xb_add(&bar[XB_TOP], 1u);
            const unsigned tg = og / nx;
            if (og + 1u == (tg + 1u) * nx) xb_add(&bar[XB_TOPGEN], 1u);
            else XB_SPIN(xb_ld(&bar[XB_TOPGEN]) == tg, bar);
            __builtin_amdgcn_fence(__ATOMIC_ACQUIRE, "agent");
            xb_add(&bar[XB_XGEN(b.x)], 1u);
            asm volatile("s_waitcnt vmcnt(0)" ::: "memory");
        } else {
            XB_SPIN(xb_ld(&bar[XB_XGEN(b.x)]) == gen, bar);
            __builtin_amdgcn_fence(__ATOMIC_ACQUIRE, "agent");
            asm volatile("s_waitcnt vmcnt(0)" ::: "memory");
        }
    }
    __syncthreads();
}

__global__ void __launch_bounds__(512, 2) k_mega(Params P) {
  __shared__ __attribute__((aligned(16))) unsigned char lds[2 * SC_SLOT + 64];
  cg::grid_group grid = cg::this_grid();
  const int bid = blockIdx.x, nb = gridDim.x, wv = threadIdx.x >> 6, lane = threadIdx.x & 63;
  unsigned char* ws = P.ws;
  volatile LAS unsigned* bst = (volatile LAS unsigned*)((LAS unsigned char*)lds + 2 * SC_SLOT);
  if (threadIdx.x < 2) bst[threadIdx.x] = 0u;
  __syncthreads();
  XcdBarrier xbar = xcd_barrier_post((unsigned*)(ws + WS_BAR), bst);
  phase_mod(P, bid, nb, (float*)lds);
  __syncthreads();
  phase_convert(P, bid * 8 + wv, nb * 8, (LAS float*)lds + wv * 2112, lane);
  if (P.ws == nullptr) grid.sync();
  xcd_barrier(xbar);
  phase_prenorm(P, bid, nb, (LAS unsigned char*)lds);
  xcd_barrier(xbar);
  { pg8::Gemm g{(const bf16_t*)(ws + WS_H), (const bf16_t*)(ws + WS_WT_IN), M, DP, D}; pg8::StaticOrder S; S.init(M, DP, nb, bid);
    pg8::EpiBf16<0> E{(bf16_t*)(ws + WS_PROJ), DP, 0};
    pg8::gemm_phase<pg8::EpiBf16<0>, pg8::StaticOrder, true, true>((PG8_LAS unsigned char*)lds, g, S, E); }
  xcd_barrier(xbar);
  for (int ci = bid; ci < 1024; ci += nb) phase_chunk_prep(P, ci, (LAS unsigned char*)lds);
  xcd_barrier(xbar);
  for (int it = bid; it < 128; it += nb) phase_scan(P, it, (LAS unsigned char*)lds);
  xcd_barrier(xbar);
  phase_gate_mix(P, bid, nb);
  xcd_barrier(xbar);
  { pg8::Gemm g{(const bf16_t*)(ws + WS_MIX), (const bf16_t*)(ws + WS_WT_OUT), M, D, D}; pg8::StaticOrder S; S.init(M, D, nb, bid);
    pg8::EpiBf16<0> E{(bf16_t*)(ws + WS_Y), D, 0};
    pg8::gemm_phase<pg8::EpiBf16<0>, pg8::StaticOrder, true, true>((PG8_LAS unsigned char*)lds, g, S, E); }
  xcd_barrier(xbar);
  phase_post1(P, bid, nb);
  xcd_barrier(xbar);
  { pg8::Gemm g{(const bf16_t*)(ws + WS_H2), (const bf16_t*)(ws + WS_WT_FF1), M, DFF, D}; pg8::StaticOrder S; S.init(M, DFF, nb, bid);
    pg8::EpiBf16<1> E{(bf16_t*)(ws + WS_HID), DFF, 0};
    pg8::gemm_phase<pg8::EpiBf16<1>, pg8::StaticOrder, true, true>((PG8_LAS unsigned char*)lds, g, S, E); }
  xcd_barrier(xbar);
  { pg8::Gemm g{(const bf16_t*)(ws + WS_HID), (const bf16_t*)(ws + WS_WT_FF2), M, D, DFF}; pg8::StaticOrder S; S.init(M, D, nb, bid);
    pg8::EpiBf16<0> E{(bf16_t*)(ws + WS_Y2), D, 0};
    pg8::gemm_phase<pg8::EpiBf16<0>, pg8::StaticOrder, true, true>((PG8_LAS unsigned char*)lds, g, S, E); }
  xcd_barrier(xbar);
  phase_final(P, bid, nb);
}

extern "C" void kernel_launch(void* const* d_in, const int* in_sizes, int n_in, void* d_out, int out_size, void* d_ws, size_t ws_size,
                              hipStream_t stream) {
  static int grid_blocks = 0;
  if (!grid_blocks) {
    int dev = 0, cus = 0, per_cu = 0;
    hipGetDevice(&dev);
    hipDeviceGetAttribute(&cus, hipDeviceAttributeMultiprocessorCount, dev);
    hipOccupancyMaxActiveBlocksPerMultiprocessor(&per_cu, (const void*)k_mega, 512, 0);
    if (per_cu < 1) per_cu = 1;
    grid_blocks = cus * per_cu;
    if (grid_blocks > 256) grid_blocks = 256;
    if (grid_blocks < 256) { int g = 1; while (g * 2 <= grid_blocks) g *= 2; grid_blocks = g; }
  }
  Params P{};
  P.x = (const float*)d_in[0]; P.c = (const float*)d_in[1]; P.w_ada = (const float*)d_in[2]; P.b_ada = (const float*)d_in[3];
  P.pre_mix_w = (const float*)d_in[4]; P.post_mix_w = (const float*)d_in[5]; P.w_in = (const float*)d_in[6];
  P.dn_conv_w = (const float*)d_in[7]; P.dn_a_log = (const float*)d_in[8]; P.dn_dt_bias = (const float*)d_in[9];
  P.dn_norm_w = (const float*)d_in[10]; P.sc_conv_w = (const float*)d_in[11]; P.w_out = (const float*)d_in[12];
  P.pre_ffn_w = (const float*)d_in[13]; P.post_ffn_w = (const float*)d_in[14]; P.w_ff1 = (const float*)d_in[15];
  P.w_ff2 = (const float*)d_in[16];
  P.out = (float*)d_out; P.ws = (unsigned char*)d_ws;
  (void)hipMemsetAsync((unsigned char*)d_ws + WS_BAR, 0, 16384, stream);
  void* args[] = {&P};
  hipError_t e = hipLaunchCooperativeKernel((const void*)k_mega, dim3(grid_blocks), dim3(512), args, 0, stream);
  if (e != hipSuccess) fprintf(stderr, "cooperative launch failed: %s (grid %d)\n", hipGetErrorString(e), grid_blocks);
}

#ifdef PHASE_TEST
__global__ void __launch_bounds__(512, 2) k_t_prep(Params P) { __shared__ __attribute__((aligned(16))) unsigned char lds[2 * SC_SLOT]; for (int ci = blockIdx.x; ci < 1024; ci += gridDim.x) phase_chunk_prep(P, ci, (LAS unsigned char*)lds); }
__global__ void __launch_bounds__(512, 2) k_t_scan(Params P) { __shared__ __attribute__((aligned(16))) unsigned char lds[2 * SC_SLOT]; for (int it = blockIdx.x; it < 128; it += gridDim.x) phase_scan(P, it, (LAS unsigned char*)lds); }
__global__ void __launch_bounds__(512, 2) k_t_pre(Params P) { __shared__ __attribute__((aligned(16))) unsigned char lds[2 * SC_SLOT]; phase_prenorm(P, blockIdx.x, gridDim.x, (LAS unsigned char*)lds); }
#endif
```
